# Optimizing an MI355X kernel written in HIP

```python
import math
import jax, jax.numpy as jnp
from jax import lax
import numpy as np

D_MODEL = 1024
BATCH = 8
SEQ = 4096
DEPTH = 2

HEAD_DIM = 128
N_Q_HEADS = 8
N_KV_HEADS = 2
GROUP = N_Q_HEADS // N_KV_HEADS
ATTN_WIDTH = N_Q_HEADS * HEAD_DIM
KV_WIDTH = N_KV_HEADS * HEAD_DIM
Q_BLOCK = 128
ROPE_THETA = 10000.0
ROPE_AXIS_DIM = HEAD_DIM // 2
GRID_W = 64
LRU_WIDTH = D_MODEL
LRU_BLOCKS = 8
LRU_BLOCK_W = LRU_WIDTH // LRU_BLOCKS
LRU_C = 8.0
CONV_WIDTH = 4
CONV_PAD_LEFT = 2
N_DIR = 2
D_FF = 2816
FFN_RES = 0.5
N_MOD = 9
EPS = 1e-6
SPLITS = [ATTN_WIDTH,
          ATTN_WIDTH + KV_WIDTH,
          ATTN_WIDTH + 2 * KV_WIDTH,
          ATTN_WIDTH + 2 * KV_WIDTH + LRU_WIDTH,
          ATTN_WIDTH + 2 * KV_WIDTH + 2 * LRU_WIDTH]
IN_COLS = ATTN_WIDTH + 2 * KV_WIDTH + 2 * LRU_WIDTH + 2 * D_MODEL

kernel_name = "hybrid_rglru_axial_gqa_macaron_encoder"


def _rmsnorm(x, g):
    xf = x.astype(jnp.float32)
    y = xf * lax.rsqrt(jnp.mean(xf * xf, axis=-1, keepdims=True) + EPS) * g.astype(jnp.float32)
    return y.astype(x.dtype)


def _modulate(h, shift, scale):
    return h * (1 + scale[:, None, :]) + shift[:, None, :]


def _swiglu(h, w_up, w_down):
    gate, up = jnp.split(h @ w_up, 2, axis=-1)
    return (jax.nn.silu(gate) * up) @ w_down


def _axial_rope_tables(S):
    rows = S // GRID_W
    row_ids = jnp.broadcast_to(jnp.arange(rows, dtype=jnp.float32)[:, None], (rows, GRID_W)).reshape(S)
    col_ids = jnp.broadcast_to(jnp.arange(GRID_W, dtype=jnp.float32)[None, :], (rows, GRID_W)).reshape(S)
    inv_freq = ROPE_THETA ** (-jnp.arange(0, ROPE_AXIS_DIM, 2, dtype=jnp.float32) / ROPE_AXIS_DIM)
    ang = jnp.concatenate([row_ids[:, None] * inv_freq, col_ids[:, None] * inv_freq], axis=-1)
    return jnp.cos(ang), jnp.sin(ang)


def _apply_rope(x, cos, sin):
    B, S, H, Dh = x.shape
    xp = x.astype(jnp.float32).reshape(B, S, H, Dh // 2, 2)
    x0, x1 = xp[..., 0], xp[..., 1]
    c = cos[None, :, None, :]
    s = sin[None, :, None, :]
    out = jnp.stack([x0 * c - x1 * s, x0 * s + x1 * c], axis=-1).reshape(B, S, H, Dh)
    return out.astype(x.dtype)


def _grid_attention(q, k, v, q_g, k_g):
    B, S = q.shape[0], q.shape[1]
    cos, sin = _axial_rope_tables(S)
    q = _apply_rope(_rmsnorm(q, q_g), cos, sin)
    k = _apply_rope(_rmsnorm(k, k_g), cos, sin)
    n_blk = S // Q_BLOCK
    qb = q.reshape(B, n_blk, Q_BLOCK, N_KV_HEADS, GROUP, HEAD_DIM).transpose(1, 0, 2, 3, 4, 5)
    scale = HEAD_DIM ** -0.5

    def one_block(qblk):
        s = jnp.einsum('bqkgd,bskd->bkgqs', qblk, k).astype(jnp.float32) * scale
        p = jax.nn.softmax(s, axis=-1).astype(v.dtype)
        return jnp.einsum('bkgqs,bskd->bqkgd', p, v)

    o = lax.map(one_block, qb)
    return o.transpose(1, 0, 2, 3, 4, 5).reshape(B, S, ATTN_WIDTH)


def _centred_dwconv(x, w, b):
    rhs = w[:, None, :].astype(x.dtype)
    y = lax.conv_general_dilated(x, rhs, window_strides=(1,),
                                 padding=[(CONV_PAD_LEFT, CONV_WIDTH - 1 - CONV_PAD_LEFT)],
                                 dimension_numbers=('NWC', 'WIO', 'NWC'),
                                 feature_group_count=LRU_WIDTH)
    return y + b


def _rg_lru(x, w_a, b_a, w_x, b_x, lam, reverse):
    B, S, W = x.shape
    xb = x.reshape(B, S, LRU_BLOCKS, LRU_BLOCK_W)
    r = jax.nn.sigmoid(jnp.einsum('bshi,hij->bshj', xb, w_a.astype(jnp.float32)) + b_a).reshape(B, S, W)
    i = jax.nn.sigmoid(jnp.einsum('bshi,hij->bshj', xb, w_x.astype(jnp.float32)) + b_x).reshape(B, S, W)
    log_a = -LRU_C * r * jax.nn.softplus(-lam.astype(jnp.float32))
    a = jnp.exp(log_a)
    u = jnp.sqrt(-jnp.expm1(2.0 * log_a)) * (i * x)

    def combine(e1, e2):
        a1, b1 = e1
        a2, b2 = e2
        return a1 * a2, a2 * b1 + b2

    _, h = lax.associative_scan(combine, (a, u), axis=1, reverse=reverse)
    return h


def _token_mixers(h, w_in, q_g, k_g, conv_w, conv_b, wa, ba, wx, bx, lam, w_attn_o, w_lru_o, w_out):
    B, S, _ = h.shape
    proj = h @ w_in
    q, k, v, lx, lg, gates = jnp.split(proj, SPLITS, axis=-1)
    attn = _grid_attention(q.reshape(B, S, N_Q_HEADS, HEAD_DIM),
                           k.reshape(B, S, N_KV_HEADS, HEAD_DIM),
                           v.reshape(B, S, N_KV_HEADS, HEAD_DIM), q_g, k_g)
    xc = _centred_dwconv(lx, conv_w, conv_b).astype(jnp.float32)
    h_lru = (_rg_lru(xc, wa[0], ba[0], wx[0], bx[0], lam[0], False)
             + _rg_lru(xc, wa[1], ba[1], wx[1], bx[1], lam[1], True))
    lru = h_lru.astype(h.dtype) * jax.nn.gelu(lg)
    g_attn, g_lru = jnp.split(jax.nn.sigmoid(gates), 2, axis=-1)
    merged = g_attn * (attn @ w_attn_o) + g_lru * (lru @ w_lru_o)
    return merged @ w_out


def setup_inputs(seed: int = 0) -> dict:
    key = jax.random.key(seed)
    ks = jax.random.split(key, 24)
    f32 = jnp.float32

    def nrm(k, shape, scale):
        return jax.random.normal(k, shape, f32) * scale

    a0 = jax.random.uniform(ks[17], (DEPTH, N_DIR, LRU_WIDTH), f32, 0.9, 0.999)
    return {
        "x": nrm(ks[0], (BATCH, SEQ, D_MODEL), 1.0),
        "c": nrm(ks[1], (BATCH, D_MODEL), 1.0),
        "ada_w": nrm(ks[2], (DEPTH, D_MODEL, N_MOD * D_MODEL), 0.5 * D_MODEL ** -0.5),
        "ada_b": nrm(ks[3], (DEPTH, N_MOD * D_MODEL), 0.02),
        "norm_g": 1.0 + nrm(ks[4], (DEPTH, 3, D_MODEL), 0.05),
        "ffn1_up": nrm(ks[5], (DEPTH, D_MODEL, 2 * D_FF), D_MODEL ** -0.5),
        "ffn1_down": nrm(ks[6], (DEPTH, D_FF, D_MODEL), D_FF ** -0.5),
        "w_in": nrm(ks[7], (DEPTH, D_MODEL, IN_COLS), D_MODEL ** -0.5),
        "q_norm_g": 1.0 + nrm(ks[8], (DEPTH, HEAD_DIM), 0.05),
        "k_norm_g": 1.0 + nrm(ks[9], (DEPTH, HEAD_DIM), 0.05),
        "conv_w": nrm(ks[10], (DEPTH, CONV_WIDTH, LRU_WIDTH), CONV_WIDTH ** -0.5),
        "conv_b": nrm(ks[11], (DEPTH, LRU_WIDTH), 0.02),
        "lru_wa": nrm(ks[12], (DEPTH, N_DIR, LRU_BLOCKS, LRU_BLOCK_W, LRU_BLOCK_W), LRU_BLOCK_W ** -0.5),
        "lru_ba": nrm(ks[13], (DEPTH, N_DIR, LRU_BLOCKS, LRU_BLOCK_W), 0.1),
        "lru_wx": nrm(ks[14], (DEPTH, N_DIR, LRU_BLOCKS, LRU_BLOCK_W, LRU_BLOCK_W), LRU_BLOCK_W ** -0.5),
        "lru_bx": nrm(ks[15], (DEPTH, N_DIR, LRU_BLOCKS, LRU_BLOCK_W), 0.1),
        "lru_lambda": jnp.log(a0) - jnp.log1p(-a0),
        "w_attn_o": nrm(ks[16], (DEPTH, ATTN_WIDTH, D_MODEL), ATTN_WIDTH ** -0.5),
        "w_lru_o": nrm(ks[18], (DEPTH, LRU_WIDTH, D_MODEL), LRU_WIDTH ** -0.5),
        "w_out": nrm(ks[19], (DEPTH, D_MODEL, D_MODEL), D_MODEL ** -0.5),
        "ffn2_up": nrm(ks[20], (DEPTH, D_MODEL, 2 * D_FF), D_MODEL ** -0.5),
        "ffn2_down": nrm(ks[21], (DEPTH, D_FF, D_MODEL), D_FF ** -0.5),
        "final_g": 1.0 + nrm(ks[22], (D_MODEL,), 0.05),
    }


def reference(x, c, ada_w, ada_b, norm_g, ffn1_up, ffn1_down, w_in, q_norm_g, k_norm_g,
              conv_w, conv_b, lru_wa, lru_ba, lru_wx, lru_bx, lru_lambda,
              w_attn_o, w_lru_o, w_out, ffn2_up, ffn2_down, final_g):
    B = x.shape[0]
    c_act = jax.nn.silu(c)
    for l in range(DEPTH):
        mod = (c_act @ ada_w[l] + ada_b[l]).reshape(B, N_MOD, D_MODEL)
        h = _modulate(_rmsnorm(x, norm_g[l, 0]), mod[:, 0], mod[:, 1])
        x = x + FFN_RES * mod[:, 2][:, None, :] * _swiglu(h, ffn1_up[l], ffn1_down[l])
        h = _modulate(_rmsnorm(x, norm_g[l, 1]), mod[:, 3], mod[:, 4])
        y = _token_mixers(h, w_in[l], q_norm_g[l], k_norm_g[l], conv_w[l], conv_b[l],
                          lru_wa[l], lru_ba[l], lru_wx[l], lru_bx[l], lru_lambda[l],
                          w_attn_o[l], w_lru_o[l], w_out[l])
        x = x + mod[:, 5][:, None, :] * y
        h = _modulate(_rmsnorm(x, norm_g[l, 2]), mod[:, 6], mod[:, 7])
        x = x + FFN_RES * mod[:, 8][:, None, :] * _swiglu(h, ffn2_up[l], ffn2_down[l])
    return _rmsnorm(x, final_g)
```

```cpp
#include <hip/hip_runtime.h>
#include <hip/hip_bf16.h>
#include <hip/hip_cooperative_groups.h>
#include <cstdio>
#include <cstdint>
namespace cg = cooperative_groups;
#ifndef MK_ONE_LAUNCH
#define MK_ONE_LAUNCH 1
#endif
__device__ __forceinline__ int opaque_tid() { int t = threadIdx.x; asm volatile("" : "+v"(t)); return t; }
#define LAS __attribute__((address_space(3)))
#define PROBE 0
#define XB_TMO      128
#define XB_XCNT(j)  (256  + 64 * (j))
#define XB_XSUB(j)  (1280 + 64 * (j))
#define XB_XGEN(j)  (2304 + 64 * (j))
#define XB_TOP      3328
#define XB_TOPGEN   3392
#define XCD_BAR_WORDS 3456
#define XB_SPIN_CAP (1u << 18)

__device__ __forceinline__ unsigned xb_ld(unsigned* p)              { return __hip_atomic_load(p, __ATOMIC_RELAXED, __HIP_MEMORY_SCOPE_AGENT); }
__device__ __forceinline__ unsigned xb_add(unsigned* p, unsigned v) { return __hip_atomic_fetch_add(p, v, __ATOMIC_RELAXED, __HIP_MEMORY_SCOPE_AGENT); }
__device__ __forceinline__ unsigned xb_xcc_id() { return (unsigned)__builtin_amdgcn_s_getreg((3 << 11) | 20) & 0xFu; }
#define XB_SPIN(cond, bar) do { unsigned _sp = 0; while (cond) { __builtin_amdgcn_s_sleep(1); \
    if ((++_sp & 255u) == 0u) { if (xb_ld(&(bar)[XB_TMO])) break; if (_sp > XB_SPIN_CAP) { atomicAdd(&(bar)[XB_TMO], 1u); break; } } } } while (0)

struct XcdBarrier {
    unsigned* bar; unsigned x;
    volatile LAS unsigned* st;
};

__device__ __forceinline__ XcdBarrier xcd_barrier_post(unsigned* bar, volatile LAS unsigned* st) {
    XcdBarrier b; b.bar = bar; b.x = xb_xcc_id(); b.st = st;
    if (threadIdx.x == 0) (void)xb_add(&bar[XB_XCNT(b.x)], 1u);
    return b;
}
__device__ __forceinline__ void xcd_barrier_complete(unsigned* bar, unsigned x, unsigned& nloc, unsigned& nx) {
    const unsigned G = gridDim.x * gridDim.y * gridDim.z;
    unsigned sum, cnt, mine, sp = 0u;
    for (;;) {
        sum = 0u; cnt = 0u; mine = 0u;
#pragma unroll
        for (unsigned j = 0; j < 16; ++j) { const unsigned c = xb_ld(&bar[XB_XCNT(j)]); sum += c; cnt += (c > 0u) ? 1u : 0u; mine = (j == x) ? c : mine; }
        if (sum == G) break;
        __builtin_amdgcn_s_sleep(1);
        if ((++sp & 255u) == 0u) { if (xb_ld(&bar[XB_TMO])) break; if (sp > XB_SPIN_CAP) { atomicAdd(&bar[XB_TMO], 1u); break; } }
    }
    nloc = mine > 0u ? mine : 1u; nx = cnt > 0u ? cnt : 1u;
}

__device__ __forceinline__ void xcd_barrier(const XcdBarrier& b) {
    asm volatile("s_waitcnt vmcnt(0)" ::: "memory");
    __syncthreads();
    if (threadIdx.x == 0) {
        unsigned* bar = b.bar;
        __builtin_amdgcn_s_waitcnt(0);
        unsigned nloc = b.st[0], nx = b.st[1];
        if (nloc == 0u) { xcd_barrier_complete(bar, b.x, nloc, nx); b.st[0] = nloc; b.st[1] = nx; }
        const unsigned old = xb_add(&bar[XB_XSUB(b.x)], 1u);
        const unsigned gen = old / nloc;
        if (old + 1u == (gen + 1u) * nloc) {
            __builtin_amdgcn_fence(__ATOMIC_RELEASE, "agent");
            asm volatile("s_waitcnt vmcnt(0)" ::: "memory");
            const unsigned og = xb_add(&bar[XB_TOP], 1u);
            const unsigned tg = og / nx;
            if (og + 1u == (tg + 1u) * nx) xb_add(&bar[XB_TOPGEN], 1u);
            else XB_SPIN(xb_ld(&bar[XB_TOPGEN]) == tg, bar);
            __builtin_amdgcn_fence(__ATOMIC_ACQUIRE, "agent");
            xb_add(&bar[XB_XGEN(b.x)], 1u);
            asm volatile("s_waitcnt vmcnt(0)" ::: "memory");
        } else {
            XB_SPIN(xb_ld(&bar[XB_XGEN(b.x)]) == gen, bar);
            __builtin_amdgcn_fence(__ATOMIC_ACQUIRE, "agent");
            asm volatile("s_waitcnt vmcnt(0)" ::: "memory");
        }
    }
    __syncthreads();
}
namespace pg8 {
#define PG8_LAS __attribute__((address_space(3)))
typedef unsigned short bf16_t;
typedef short bf16x8 __attribute__((ext_vector_type(8)));
typedef float f32x4 __attribute__((ext_vector_type(4)));
typedef unsigned u32x4 __attribute__((ext_vector_type(4)));
constexpr int BM = 256, BK = 64, HALF = 128, HTB = HALF * BK * 2  , STAGE_BYTES = 8 * HTB, NXCD = 8, WGM = 8;

__host__ __device__ __forceinline__ int lds_byte(int r, int c) { const int st = (r >> 4) * 2 + (c >> 5), rr = r & 15, cc = c & 31, ob = rr * 64 + cc * 2; return st * 1024 + (ob ^ (((ob >> 9) & 1) << 5)); }
__host__ __device__ __forceinline__ void stage_rc(int b, int& R, int& C) { const int st = b / 1024, sb = b % 1024, swz = sb ^ (((sb >> 9) & 1) << 5); R = (st >> 1) * 16 + swz / 64; C = (st & 1) * 32 + (swz % 64) / 2; }
__host__ __device__ __forceinline__ int perm32(int rho) { const int n = rho >> 4, i = rho & 15; return 8 * (i >> 2) + 4 * n + (i & 3); }

struct Unit { int pm, pn; };
struct Gemm { const bf16_t* A; const bf16_t* Bt; int M, N, K; };

struct StaticOrder {
    int nM, nN, nwg, G, c;
    __host__ __device__ void init(int M, int N, int G_, int c_) { nM = M / BM; nN = N / BM; nwg = nM * nN; G = G_; c = c_; }
    __host__ __device__ bool next(int i, Unit& u) const {
        const long L = (long)i * G + c; if (L >= nwg) return false;
        int wgid = (int)L; { const int q = nwg / NXCD, r = nwg % NXCD, xcd = wgid % NXCD, off = wgid / NXCD; wgid = (xcd < r ? xcd * (q + 1) : r * (q + 1) + (xcd - r) * q) + off; }
        const int nig = WGM * nN, gid = wgid / nig, fm = gid * WGM, gsz = (nM - fm) < WGM ? (nM - fm) : WGM;
        u.pm = fm + ((wgid % nig) % gsz); u.pn = (wgid % nig) / gsz; return true;
    }
    __device__ __forceinline__ void a_ready(const Unit&) const {}
    __device__ __forceinline__ void done(const Unit&) const {}
};

__device__ __forceinline__ unsigned cvt_pk_bf16(float lo, float hi) { unsigned r; asm volatile("v_cvt_pk_bf16_f32 %0, %1, %2" : "=v"(r) : "v"(lo), "v"(hi)); return r; }
typedef float f32x2 __attribute__((ext_vector_type(2)));
__device__ __forceinline__ f32x2 gelu_pk(f32x2 v) {
    const f32x2 av = __builtin_elementwise_abs(v), d = av * 0.2316418882f + 1.0f;
    f32x2 t; t.x = __builtin_amdgcn_rcpf(d.x); t.y = __builtin_amdgcn_rcpf(d.y);
    f32x2 q = t * 0.5307027145f + (-0.7265760135f); q = q * t + 0.7107068705f; q = q * t + (-0.142248368f); q = q * t + 0.127414796f; q = q * t;
    const f32x2 s = (v * v) * (-0.72134752044f);
    f32x2 e; e.x = __builtin_amdgcn_exp2f(s.x); e.y = __builtin_amdgcn_exp2f(s.y);
    const f32x2 m = v * (q * e), r = v - m;
    f32x2 o; o.x = v.x < 0.f ? m.x : r.x; o.y = v.y < 0.f ? m.y : r.y; return o;
}

template <int ACT  > struct EpiBf16 {
    static constexpr bool PERM = true, AFTER_DRAIN = false; static_assert(ACT == 0 || ACT == 1, "EpiBf16: ACT is 0 (none) or 1 (gelu_pk)");
    bf16_t* O; int ldc; const float* bias; int split_cols; size_t split_stride; float scale0;
    __device__ __forceinline__ void operator()(const f32x4 (&acc)[2][2][4][2], const Unit& u, int wr, int wc, int fr, int fq) const {
        const int row0 = u.pm * BM + wr * 64 + fr; int colt = u.pn * BM; bf16_t* base = O;
        float sc = 1.f; if (split_cols) { const int t = colt / split_cols; base += (size_t)t * split_stride; colt -= t * split_cols; if (t == 0) sc = scale0; }
        const int col0 = colt + wc * 32 + 8 * fq, bcol0 = u.pn * BM + wc * 32 + 8 * fq;
        f32x4 bv[2][2];
#pragma unroll
        for (int bj = 0; bj < 2; ++bj)
#pragma unroll
            for (int n = 0; n < 2; ++n) bv[bj][n] = bias ? *(const f32x4*)(bias + bcol0 + bj * HALF + 4 * n) : (f32x4){0.f, 0.f, 0.f, 0.f};
#pragma unroll
        for (int ai = 0; ai < 2; ++ai)
#pragma unroll
            for (int m = 0; m < 4; ++m) { bf16_t* rowp = base + (size_t)(row0 + ai * HALF + m * 16) * ldc + col0;
#pragma unroll
                for (int bj = 0; bj < 2; ++bj) { f32x4 v0 = acc[ai][bj][m][0] + bv[bj][0], v1 = acc[ai][bj][m][1] + bv[bj][1];
                    if (ACT == 1) { f32x2 a = gelu_pk((f32x2){v0[0], v0[1]}), b = gelu_pk((f32x2){v0[2], v0[3]}), c = gelu_pk((f32x2){v1[0], v1[1]}), d = gelu_pk((f32x2){v1[2], v1[3]});
                        v0 = (f32x4){a.x, a.y, b.x, b.y}; v1 = (f32x4){c.x, c.y, d.x, d.y}; }
                    v0 = v0 * sc; v1 = v1 * sc; u32x4 w; w.x = cvt_pk_bf16(v0[0], v0[1]); w.y = cvt_pk_bf16(v0[2], v0[3]); w.z = cvt_pk_bf16(v1[0], v1[1]); w.w = cvt_pk_bf16(v1[2], v1[3]);
                    *(u32x4*)(rowp + bj * HALF) = w; } }
    }
};
template <class Epi, class Sched, bool ALIGN_EPI = false, bool SP2 = false>
__device__ __forceinline__ void gemm_phase(PG8_LAS unsigned char* lds, const Gemm g, const Sched& S, const Epi& E) {
    const int tid = opaque_tid(), wid = __builtin_amdgcn_readfirstlane(tid >> 6), lane = tid & 63, wr = wid >> 2, wc = wid & 3, fr = lane & 15, fq = lane >> 4;
    const int K = g.K, nt = K / BK;
    unsigned voffA[2], voffB[2];
#pragma unroll
    for (int i = 0; i < 2; ++i) { int R, C; stage_rc(tid * 16 + i * 8192, R, C); const int Rb = Epi::PERM ? ((R & ~31) + perm32(R & 31)) : R;
        voffA[i] = (unsigned)(R * K + C) * 2u; voffB[i] = (unsigned)(Rb * K + C) * 2u; }
    const unsigned kstep = (unsigned)(BK * 2);
    const unsigned hstep = (unsigned)HALF * K * 2;
    const unsigned tstep = 2 * hstep;
    const __amdgpu_buffer_rsrc_t rA = __builtin_amdgcn_make_buffer_rsrc((void*)g.A, (short)0, (int)((size_t)g.M * K * 2), 0x00020000);
    const __amdgpu_buffer_rsrc_t rB = __builtin_amdgcn_make_buffer_rsrc((void*)g.Bt, (short)0, (int)((size_t)g.N * K * 2), 0x00020000);
    const unsigned ldsw = (unsigned)wid * 1024u;
    const int aoff = lds_byte(wr * 64 + fr, fq * 8), boff = lds_byte(wc * 32 + fr, fq * 8);
#define PG8_SA(b, h) (((b) * 2 + (h)) * HTB)
#define PG8_SB(b, h) ((4 + (b) * 2 + (h)) * HTB)
#define PG8_STAGEX(bufoff, rs, soff, voff) do { _Pragma("unroll") for (int _i = 0; _i < 2; ++_i) \
        __builtin_amdgcn_raw_ptr_buffer_load_lds(rs, (PG8_LAS unsigned*)(lds + (bufoff) + ldsw + _i * 8192), 16, (int)(voff)[_i], (int)(soff), 0, 0); } while (0)
#define PG8_LDA(dst, b, h) do { _Pragma("unroll") for (int m = 0; m < 4; ++m) _Pragma("unroll") for (int k = 0; k < 2; ++k) dst[m][k] = *(const PG8_LAS bf16x8*)(lds + PG8_SA(b, h) + aoff + m * 2048 + k * 1024); } while (0)
#define PG8_LDB(dst, b, h) do { _Pragma("unroll") for (int n = 0; n < 2; ++n) _Pragma("unroll") for (int k = 0; k < 2; ++k) dst[n][k] = *(const PG8_LAS bf16x8*)(lds + PG8_SB(b, h) + boff + n * 2048 + k * 1024); } while (0)
#define PG8_MMA(ai, bj, At, Bt) do { __builtin_amdgcn_s_setprio(1); _Pragma("unroll") for (int m = 0; m < 4; ++m) _Pragma("unroll") for (int n = 0; n < 2; ++n) _Pragma("unroll") for (int k = 0; k < 2; ++k) \
        acc[ai][bj][m][n] = __builtin_amdgcn_mfma_f32_16x16x32_bf16(Bt[n][k], At[m][k], acc[ai][bj][m][n], 0, 0, 0); __builtin_amdgcn_s_setprio(0); } while (0)
#define PG8_WAIT_V(n) asm volatile("s_waitcnt vmcnt(" #n ")" ::: "memory")
#define PG8_WAIT_L(n) asm volatile("s_waitcnt lgkmcnt(" #n ")" ::: "memory")
#define PG8_BAR __builtin_amdgcn_s_barrier()
#define PG8_SCHED __builtin_amdgcn_sched_barrier(0)
    Unit cur, nxt; int ui = 0;
    if (!S.next(0, cur)) return;
    f32x4 acc[2][2][4][2];
#pragma unroll
    for (int a = 0; a < 2; ++a)
#pragma unroll
        for (int b = 0; b < 2; ++b)
#pragma unroll
            for (int m = 0; m < 4; ++m)
#pragma unroll
                for (int n = 0; n < 2; ++n) acc[a][b][m][n] = (f32x4){0.f, 0.f, 0.f, 0.f};
    bf16x8 At[4][2], B0[2][2], B1[2][2];
    unsigned cA = (unsigned)cur.pm * tstep, cB = (unsigned)cur.pn * tstep;
    S.a_ready(cur);
    if constexpr (SP2) {
        PG8_STAGEX(PG8_SB(0, 0), rB, cB, voffB); PG8_STAGEX(PG8_SB(0, 1), rB, cB + hstep, voffB); PG8_STAGEX(PG8_SA(0, 0), rA, cA, voffA); PG8_STAGEX(PG8_SA(0, 1), rA, cA + hstep, voffA);
        if (wr == 1) PG8_BAR;
        PG8_WAIT_V(2); PG8_BAR;
        PG8_STAGEX(PG8_SB(1, 0), rB, cB + kstep, voffB); PG8_STAGEX(PG8_SA(1, 0), rA, cA + kstep, voffA); PG8_STAGEX(PG8_SB(1, 1), rB, cB + hstep + kstep, voffB);
        PG8_WAIT_V(6); PG8_BAR;
    } else {
        PG8_STAGEX(PG8_SB(0, 0), rB, cB, voffB); PG8_STAGEX(PG8_SA(0, 0), rA, cA, voffA); PG8_STAGEX(PG8_SB(0, 1), rB, cB + hstep, voffB); PG8_STAGEX(PG8_SA(0, 1), rA, cA + hstep, voffA);
        if (wr == 1) PG8_BAR;
        PG8_WAIT_V(4); PG8_BAR;
        PG8_STAGEX(PG8_SB(1, 0), rB, cB + kstep, voffB); PG8_STAGEX(PG8_SA(1, 0), rA, cA + kstep, voffA); PG8_STAGEX(PG8_SB(1, 1), rB, cB + hstep + kstep, voffB);
        PG8_WAIT_V(6); PG8_BAR;
    }
    for (;;) {
        const bool has_next = S.next(ui + 1, nxt);
        const unsigned nA = has_next ? (unsigned)nxt.pm * tstep : cA, nB = has_next ? (unsigned)nxt.pn * tstep : cB;
        for (int t = 0; t < nt; t += 2) {
            const bool last = (t == nt - 2);
            const unsigned a1 = cA + (unsigned)(t + 1) * kstep;
            const unsigned a2 = last ? nA : cA + (unsigned)(t + 2) * kstep, b2 = last ? nB : cB + (unsigned)(t + 2) * kstep;
            const unsigned a3 = a2 + kstep, b3 = b2 + kstep;
            if (last && has_next) S.a_ready(nxt);
            if constexpr (SP2) {
            PG8_LDB(B0, 0, 0); PG8_LDB(B1, 0, 1); PG8_SCHED; PG8_LDA(At, 0, 0); PG8_STAGEX(PG8_SA(1, 1), rA, a1 + hstep, voffA);
            PG8_WAIT_V(8); PG8_WAIT_L(0); PG8_BAR; PG8_MMA(0, 0, At, B0); PG8_MMA(0, 1, At, B1); PG8_BAR; PG8_SCHED;
            PG8_LDA(At, 0, 1); PG8_STAGEX(PG8_SB(0, 0), rB, b2, voffB); PG8_STAGEX(PG8_SB(0, 1), rB, b2 + hstep, voffB); PG8_STAGEX(PG8_SA(0, 0), rA, a2, voffA);
            PG8_WAIT_V(8); PG8_WAIT_L(0); PG8_BAR; PG8_MMA(1, 0, At, B0); PG8_MMA(1, 1, At, B1); PG8_BAR; PG8_SCHED;
            PG8_LDB(B0, 1, 0); PG8_LDB(B1, 1, 1); PG8_SCHED; PG8_LDA(At, 1, 0); PG8_STAGEX(PG8_SA(0, 1), rA, a2 + hstep, voffA);
            PG8_WAIT_V(8); PG8_WAIT_L(0); PG8_BAR; PG8_MMA(0, 0, At, B0); PG8_MMA(0, 1, At, B1); PG8_BAR; PG8_SCHED;
            PG8_LDA(At, 1, 1); PG8_STAGEX(PG8_SB(1, 0), rB, b3, voffB); PG8_STAGEX(PG8_SB(1, 1), rB, b3 + hstep, voffB); PG8_STAGEX(PG8_SA(1, 0), rA, a3, voffA);
            PG8_WAIT_V(8); PG8_WAIT_L(0); PG8_BAR; PG8_MMA(1, 0, At, B0); PG8_MMA(1, 1, At, B1); PG8_BAR; PG8_SCHED;
            } else {
            PG8_LDB(B0, 0, 0); PG8_SCHED; PG8_LDA(At, 0, 0); PG8_STAGEX(PG8_SA(1, 1), rA, a1 + hstep, voffA);
            PG8_WAIT_L(8); PG8_BAR; PG8_WAIT_L(0); PG8_MMA(0, 0, At, B0); PG8_BAR; PG8_SCHED;
            PG8_LDB(B1, 0, 1); PG8_STAGEX(PG8_SB(0, 0), rB, b2, voffB);
            PG8_BAR; PG8_WAIT_L(0); PG8_MMA(0, 1, At, B1); PG8_BAR;
            PG8_LDA(At, 0, 1); PG8_STAGEX(PG8_SA(0, 0), rA, a2, voffA);
            PG8_BAR; PG8_WAIT_L(0); PG8_MMA(1, 0, At, B0); PG8_BAR; PG8_SCHED;
            PG8_STAGEX(PG8_SB(0, 1), rB, b2 + hstep, voffB);
            PG8_WAIT_V(6); PG8_BAR; PG8_MMA(1, 1, At, B1); PG8_BAR;
            PG8_LDB(B0, 1, 0); PG8_SCHED; PG8_LDA(At, 1, 0); PG8_STAGEX(PG8_SA(0, 1), rA, a2 + hstep, voffA);
            PG8_WAIT_L(8); PG8_BAR; PG8_WAIT_L(0); PG8_MMA(0, 0, At, B0); PG8_BAR; PG8_SCHED;
            PG8_LDB(B1, 1, 1); PG8_STAGEX(PG8_SB(1, 0), rB, b3, voffB);
            PG8_BAR; PG8_WAIT_L(0); PG8_MMA(0, 1, At, B1); PG8_BAR;
            PG8_LDA(At, 1, 1); PG8_STAGEX(PG8_SA(1, 0), rA, a3, voffA);
            PG8_BAR; PG8_WAIT_L(0); PG8_MMA(1, 0, At, B0); PG8_BAR; PG8_SCHED;
            PG8_STAGEX(PG8_SB(1, 1), rB, b3 + hstep, voffB);
            PG8_WAIT_V(6); PG8_BAR; PG8_MMA(1, 1, At, B1); PG8_BAR;
            }
        }
        if constexpr (ALIGN_EPI) { if (wr == 0) PG8_BAR; }
        if constexpr (!Epi::AFTER_DRAIN) { E(acc, cur, wr, wc, fr, fq); S.done(cur); }
        if (!has_next) break;
#pragma unroll
        for (int a = 0; a < 2; ++a)
#pragma unroll
            for (int b = 0; b < 2; ++b)
#pragma unroll
                for (int m = 0; m < 4; ++m)
#pragma unroll
                    for (int n = 0; n < 2; ++n) acc[a][b][m][n] = (f32x4){0.f, 0.f, 0.f, 0.f};
        cur = nxt; cA = nA; cB = nB; ++ui;
        if constexpr (ALIGN_EPI) { if (wr == 1) PG8_BAR; }
    }
    PG8_WAIT_V(0);
    if constexpr (!ALIGN_EPI) { if (wr == 0) PG8_BAR; }
    PG8_BAR;
    if constexpr (Epi::AFTER_DRAIN) { E.fused(acc, cur, wr, wc, fr, fq, lds, wid, lane); S.done(cur); }
#undef PG8_SA
#undef PG8_SB
#undef PG8_STAGEX
#undef PG8_LDA
#undef PG8_LDB
#undef PG8_MMA
#undef PG8_WAIT_V
#undef PG8_WAIT_L
#undef PG8_BAR
#undef PG8_SCHED
}
}
namespace att {
typedef unsigned short bf16;
constexpr int   D = 128, NW = 8, QBLK = 32, KVBLK = 64;
constexpr float SCALE = 0.088388347648318440f;
constexpr float THR = 8.f;
constexpr int LDQ = 1024, LDK = 256, LDO = 1024;
constexpr size_t SHM_V = KVBLK * D * 2, SHM_K = KVBLK * D * 2, SHM_ATTN = 2 * SHM_V + 2 * SHM_K + NW * 64 * 4;
using bf16x8 = __attribute__((ext_vector_type(8))) short;
using s16x4  = __attribute__((ext_vector_type(4))) short;
using f32x16 = __attribute__((ext_vector_type(16))) float;
using u32x4  = __attribute__((ext_vector_type(4))) unsigned;
#define KSWZ(row, colB) ((row) * 256 + ((colB) ^ (((row) & 7) << 4)))
#define SBAR() __builtin_amdgcn_sched_barrier(0)
__device__ __forceinline__ int crow(int r, int hi) { return (r & 3) + 8 * (r >> 2) + 4 * hi; }
__device__ __forceinline__ unsigned cvtpk(float lo, float hi) {
  unsigned r; asm volatile("v_cvt_pk_bf16_f32 %0, %1, %2" : "=v"(r) : "v"(lo), "v"(hi)); return r;
}
__device__ __forceinline__ bf16x8 ld8(const bf16* p) { return *reinterpret_cast<const bf16x8*>(p); }

constexpr float THRL = THR * 1.4426950408889634f;
template <bool FIRST>
__device__ __forceinline__ void partialSM(f32x16& p0, f32x16& p1, float& m_reg, f32x16& negm, float& alpha) {
  float pmax = p0[0]; for (int r = 1; r < 16; ++r) pmax = fmaxf(pmax, p0[r]); for (int r = 0; r < 16; ++r) pmax = fmaxf(pmax, p1[r]);
  { auto rr = __builtin_amdgcn_permlane32_swap(__float_as_uint(pmax), __float_as_uint(pmax), false, false);
    pmax = fmaxf(__uint_as_float(rr[0]), __uint_as_float(rr[1])); }
  if (!FIRST && __builtin_expect(__all(pmax <= THRL), 1)) { alpha = 1.f; }
  else {
    const float d = FIRST ? pmax : fmaxf(pmax, 0.f);
    alpha = FIRST ? 1.f : __builtin_amdgcn_exp2f(-d);
    m_reg += d;
    for (int r = 0; r < 16; ++r) p0[r] -= d; for (int r = 0; r < 16; ++r) p1[r] -= d;
    const float nm = -m_reg; for (int r = 0; r < 16; ++r) negm[r] = nm;
  }
  for (int r = 0; r < 16; ++r) p0[r] = __builtin_amdgcn_exp2f(p0[r]);
}
__device__ __forceinline__ void finishSM(f32x16& p0, f32x16& p1, float alpha, float& l_reg, bf16x8& pa0, bf16x8& pa1, bf16x8& pa2, bf16x8& pa3) {
  for (int r = 0; r < 16; ++r) p1[r] = __builtin_amdgcn_exp2f(p1[r]);
  float ps = 0; for (int r = 0; r < 16; ++r) ps += p0[r]; for (int r = 0; r < 16; ++r) ps += p1[r];
  { auto rr = __builtin_amdgcn_permlane32_swap(__float_as_uint(ps), __float_as_uint(ps), false, false);
    ps = __uint_as_float(rr[0]) + __uint_as_float(rr[1]); }
  l_reg = l_reg * alpha + ps;
#define PK4(P, BASE, OUT) do { unsigned a0 = cvtpk(P[BASE + 0], P[BASE + 1]), a1 = cvtpk(P[BASE + 2], P[BASE + 3]);   \
    unsigned b0 = cvtpk(P[BASE + 4], P[BASE + 5]), b1 = cvtpk(P[BASE + 6], P[BASE + 7]);                              \
    auto r0 = __builtin_amdgcn_permlane32_swap(a0, b0, false, false); auto r1 = __builtin_amdgcn_permlane32_swap(a1, b1, false, false); \
    u32x4 w = {r0[0], r1[0], r0[1], r1[1]}; OUT = *reinterpret_cast<bf16x8*>(&w); } while (0)
  PK4(p0, 0, pa0); PK4(p0, 8, pa1); PK4(p1, 0, pa2); PK4(p1, 8, pa3);
#undef PK4
}
__device__ __forceinline__ void qkt(f32x16& p0, f32x16& p1, const bf16* Ks, const bf16x8* qr, const f32x16& negm, int r32, int hi) {
#pragma unroll
  for (int d0 = 0; d0 < 8; ++d0) { int cb = (d0 * 16 + hi * 8) * 2;
    bf16x8 b0 = *reinterpret_cast<const bf16x8*>((const char*)Ks + KSWZ(r32, cb));
    bf16x8 b1 = *reinterpret_cast<const bf16x8*>((const char*)Ks + KSWZ(32 + r32, cb));
    if (d0 == 0) { p0 = __builtin_amdgcn_mfma_f32_32x32x16_bf16(b0, qr[0], negm, 0, 0, 0); p1 = __builtin_amdgcn_mfma_f32_32x32x16_bf16(b1, qr[0], negm, 0, 0, 0); }
    else { p0 = __builtin_amdgcn_mfma_f32_32x32x16_bf16(b0, qr[d0], p0, 0, 0, 0); p1 = __builtin_amdgcn_mfma_f32_32x32x16_bf16(b1, qr[d0], p1, 0, 0, 0); } }
}
__device__ __forceinline__ int v_st(int k, int c) { const int kk = (k & ~0xC) | ((k & 4) << 1) | ((k & 8) >> 1); return ((kk >> 3) * 4 + (c >> 5)) * 512 + ((kk & 7) * 32 + (c & 31)) * 2; }
__device__ __forceinline__ int v_rd_base(int lane) { return ((lane & 3) << 3) | (((lane >> 2) & 3) << 6) | (((lane >> 4) & 1) << 5) | (((lane >> 5) & 1) << 8); }
constexpr int v_rd_off(int d0, int ks, int half) { return d0 * 512 + ks * 4096 + half * 2048; }
template <int OFF> __device__ __forceinline__ s16x4 tr_read(int vb) {
  s16x4 r; asm volatile("ds_read_b64_tr_b16 %0, %1 offset:%2" : "=&v"(r) : "v"(vb), "i"(OFF) : "memory"); return r;
}
template <int D0> __device__ __forceinline__ void pv_one(f32x16& od, int vb, bf16x8 pa0, bf16x8 pa1, bf16x8 pa2, bf16x8 pa3) {
  const s16x4 l0 = tr_read<v_rd_off(D0, 0, 0)>(vb), h0 = tr_read<v_rd_off(D0, 0, 1)>(vb), l1 = tr_read<v_rd_off(D0, 1, 0)>(vb), h1 = tr_read<v_rd_off(D0, 1, 1)>(vb);
  const s16x4 l2 = tr_read<v_rd_off(D0, 2, 0)>(vb), h2 = tr_read<v_rd_off(D0, 2, 1)>(vb), l3 = tr_read<v_rd_off(D0, 3, 0)>(vb), h3 = tr_read<v_rd_off(D0, 3, 1)>(vb);
  asm volatile("s_waitcnt lgkmcnt(0)" ::: "memory"); SBAR();
#define PK(L, H) (bf16x8){L[0], L[1], L[2], L[3], H[0], H[1], H[2], H[3]}
  od = __builtin_amdgcn_mfma_f32_32x32x16_bf16(pa0, PK(l0, h0), od, 0, 0, 0);
  od = __builtin_amdgcn_mfma_f32_32x32x16_bf16(pa1, PK(l1, h1), od, 0, 0, 0);
  od = __builtin_amdgcn_mfma_f32_32x32x16_bf16(pa2, PK(l2, h2), od, 0, 0, 0);
  od = __builtin_amdgcn_mfma_f32_32x32x16_bf16(pa3, PK(l3, h3), od, 0, 0, 0);
#undef PK
}
__device__ __forceinline__ void pv_d0(f32x16* o, int vb, bf16x8 pa0, bf16x8 pa1, bf16x8 pa2, bf16x8 pa3) {
  pv_one<0>(o[0], vb, pa0, pa1, pa2, pa3); pv_one<1>(o[1], vb, pa0, pa1, pa2, pa3); pv_one<2>(o[2], vb, pa0, pa1, pa2, pa3); pv_one<3>(o[3], vb, pa0, pa1, pa2, pa3);
}

__device__ __forceinline__ void attn_dense_body(const bf16* Qb, const bf16* __restrict__ Kh, const bf16* __restrict__ Vh,
                                                bf16* Ob, int seq, char* lds, const float* __restrict__ qg, const float* __restrict__ rope, int s0) {
  const int tid = opaque_tid(), wid = tid >> 6, lane = tid & 63, r32 = lane & 31, hi = lane >> 5;
  bf16* V_lds = (bf16*)lds; bf16* K_lds = (bf16*)(lds + 2 * SHM_V);
  float* ws = (float*)(lds + 2 * SHM_V + 2 * SHM_K) + wid * 64; float* li_l = ws; float* al_l = ws + 32;
  float m_reg = 0.f, l_reg = 0; f32x16 o[4] = {}; f32x16 negm = {}; bf16x8 qr[8];
  const bf16* Qw = Qb + (long)(wid * QBLK + r32) * LDQ + hi * 8;
#pragma unroll
  for (int d0 = 0; d0 < 8; ++d0) qr[d0] = ld8(Qw + d0 * 16);
  {
    float ss = 0.f;
#pragma unroll
    for (int d0 = 0; d0 < 8; ++d0)
#pragma unroll
      for (int e = 0; e < 8; ++e) { const float x = __uint_as_float((unsigned)(unsigned short)qr[d0][e] << 16); ss += x * x; }
    { auto rr = __builtin_amdgcn_permlane32_swap(__float_as_uint(ss), __float_as_uint(ss), false, false); ss = __uint_as_float(rr[0]) + __uint_as_float(rr[1]); }
    const float rstd = rsqrtf(ss * (1.f / 128.f) + 1e-6f) * (SCALE * 1.4426950408889634f);
    const float* rp = rope + (long)(s0 + wid * QBLK + r32) * 128 + hi * 8;
    const float* gp = qg + hi * 8;
#pragma unroll
    for (int d0 = 0; d0 < 8; ++d0) {
      const float4 g0 = *reinterpret_cast<const float4*>(gp + d0 * 16), g1 = *reinterpret_cast<const float4*>(gp + d0 * 16 + 4);
      const float4 c0 = *reinterpret_cast<const float4*>(rp + d0 * 16), c1 = *reinterpret_cast<const float4*>(rp + d0 * 16 + 4);
      const float gg[8] = {g0.x, g0.y, g0.z, g0.w, g1.x, g1.y, g1.z, g1.w};
      const float cs[8] = {c0.x, c0.y, c0.z, c0.w, c1.x, c1.y, c1.z, c1.w};
      unsigned w[4];
#pragma unroll
      for (int p = 0; p < 4; ++p) {
        const float y0 = __uint_as_float((unsigned)(unsigned short)qr[d0][2 * p] << 16) * rstd * gg[2 * p], y1 = __uint_as_float((unsigned)(unsigned short)qr[d0][2 * p + 1] << 16) * rstd * gg[2 * p + 1];
        w[p] = cvtpk(y0 * cs[2 * p] - y1 * cs[2 * p + 1], y0 * cs[2 * p + 1] + y1 * cs[2 * p]);
      }
      u32x4 ww = {w[0], w[1], w[2], w[3]}; qr[d0] = *reinterpret_cast<bf16x8*>(&ww);
    }
  }
  const int sr = tid >> 4, sc = (tid & 15) * 8, vst0 = v_st(sr, sc), vst1 = v_st(32 + sr, sc);
  const int vb0 = (int)(uintptr_t)V_lds + v_rd_base(lane);
  struct { bf16x8 vs0, vs1, ks0, ks1; } sr_[1];
  const __amdgpu_buffer_rsrc_t srK = __builtin_amdgcn_make_buffer_rsrc((void*)Kh, (short)0, seq * LDK * 2, 0x00020000);
  const __amdgpu_buffer_rsrc_t srV = __builtin_amdgcn_make_buffer_rsrc((void*)Vh, (short)0, seq * LDK * 2, 0x00020000);
  const unsigned kvoff = (unsigned)(sr * LDK + sc) * 2u;
#define BLD8(rs, vo, so) __builtin_bit_cast(bf16x8, __builtin_amdgcn_raw_buffer_load_b128(rs, vo, so, 0))
#define SLOAD(i, k0) do { const unsigned so_ = (unsigned)(k0) * (LDK * 2); \
    sr_[i].vs0 = BLD8(srV, kvoff, so_); sr_[i].vs1 = BLD8(srV, kvoff + 32u * LDK * 2u, so_); \
    sr_[i].ks0 = BLD8(srK, kvoff, so_); sr_[i].ks1 = BLD8(srK, kvoff + 32u * LDK * 2u, so_); } while (0)
#define SWRITE(b, i) do { *(bf16x8*)((char*)V_lds + (b) * SHM_V + vst0) = sr_[i].vs0;          \
    *(bf16x8*)((char*)V_lds + (b) * SHM_V + vst1) = sr_[i].vs1; int kc = sc * 2;               \
    *(bf16x8*)((char*)K_lds + (b) * SHM_K + KSWZ(sr, kc)) = sr_[i].ks0;                       \
    *(bf16x8*)((char*)K_lds + (b) * SHM_K + KSWZ(32 + sr, kc)) = sr_[i].ks1; } while (0)
#define SWAIT() asm volatile("s_waitcnt vmcnt(0)" ::: "memory")
#define RESC(a) do { if (__any((a) < 1.f)) { if (hi == 0) al_l[r32] = (a); asm volatile("s_waitcnt lgkmcnt(0)" ::: "memory"); \
    for (int d = 0; d < 4; ++d) for (int r = 0; r < 16; ++r) o[d][r] *= al_l[crow(r, hi)]; } } while (0)
  f32x16 pA0, pA1, pB0, pB1; float alA, alB; bf16x8 pa0, pa1, pa2, pa3; const int NT = seq / KVBLK;
  constexpr int SE = 0, SO = 0;
  SLOAD(SE, 0); asm volatile("s_waitcnt vmcnt(0)" ::: "memory"); SWRITE(0, SE); __syncthreads();
  qkt(pA0, pA1, K_lds, qr, negm, r32, hi); partialSM<true>(pA0, pA1, m_reg, negm, alA);
  SLOAD(SO, KVBLK);
  SWAIT(); SWRITE(1, SO); __syncthreads();
  for (int j = 1; j + 1 < NT; j += 2) {
    SBAR(); qkt(pB0, pB1, (bf16*)((char*)K_lds + SHM_K), qr, negm, r32, hi);
    finishSM(pA0, pA1, alA, l_reg, pa0, pa1, pa2, pa3); SBAR();
    SLOAD(SO, (j + 1) * KVBLK); SBAR();
    pv_d0(o, vb0, pa0, pa1, pa2, pa3); partialSM<false>(pB0, pB1, m_reg, negm, alB);
    __syncthreads(); SWAIT(); SWRITE(0, SE);
    RESC(alB); __syncthreads();
    SBAR(); qkt(pA0, pA1, K_lds, qr, negm, r32, hi);
    finishSM(pB0, pB1, alB, l_reg, pa0, pa1, pa2, pa3); SBAR();
    SLOAD(SE, (j + 2) * KVBLK); SBAR();
    pv_d0(o, vb0 + (int)SHM_V, pa0, pa1, pa2, pa3); partialSM<false>(pA0, pA1, m_reg, negm, alA);
    __syncthreads(); SWAIT(); SWRITE(1, SO);
    RESC(alA); __syncthreads();
  }
  SBAR(); qkt(pB0, pB1, (bf16*)((char*)K_lds + SHM_K), qr, negm, r32, hi);
  finishSM(pA0, pA1, alA, l_reg, pa0, pa1, pa2, pa3); SBAR();
  pv_d0(o, vb0, pa0, pa1, pa2, pa3); partialSM<false>(pB0, pB1, m_reg, negm, alB);
  __syncthreads(); RESC(alB);
  finishSM(pB0, pB1, alB, l_reg, pa0, pa1, pa2, pa3); SBAR();
  pv_d0(o, vb0 + (int)SHM_V, pa0, pa1, pa2, pa3);
  if (hi == 0) li_l[r32] = l_reg; asm volatile("s_waitcnt lgkmcnt(0)" ::: "memory");
  float rli[16];
#pragma unroll
  for (int r = 0; r < 16; ++r) rli[r] = __builtin_amdgcn_rcpf(li_l[crow(r, hi)]);
  bf16* Ow = Ob + (long)(wid * QBLK) * LDO;
#pragma unroll
  for (int r = 0; r < 16; ++r) { int orow = crow(r, hi);
#pragma unroll
    for (int d0 = 0; d0 < 4; d0 += 2) {
      const unsigned w0 = cvtpk(o[d0][r] * rli[r], o[d0 + 1][r] * rli[r]);
      Ow[(long)orow * LDO + d0 * 32 + r32] = (bf16)(w0 & 0xffffu);
      Ow[(long)orow * LDO + (d0 + 1) * 32 + r32] = (bf16)(w0 >> 16);
    } }
#undef SLOAD
#undef BLD8
#undef SWRITE
#undef SWAIT
#undef RESC
}
#undef KSWZ
#undef SBAR
}
typedef unsigned short bf16_t;
typedef float f32x4 __attribute__((ext_vector_type(4)));
typedef float f32x2 __attribute__((ext_vector_type(2)));
typedef unsigned u32x4 __attribute__((ext_vector_type(4)));
typedef unsigned u32x2 __attribute__((ext_vector_type(2)));
typedef short bf16x8 __attribute__((ext_vector_type(8)));

constexpr int DM = 1024, NB = 8, SEQ = 4096, NT_TOK = NB * SEQ, DFF = 2816, NUP = 2 * DFF, INC = 5632, NMODV = 9 * DM;
constexpr int NWAVES = 8, NTHR = 512;
constexpr float EPSN = 1e-6f;
constexpr size_t MiB = 1u << 20;
constexpr size_t WS_BAR = 0, BAR_BYTES = 16384;
constexpr size_t WS_CNT = 16384;
constexpr size_t WS_RSS = 65536;
constexpr size_t WS_MOD = 1 * MiB;
constexpr size_t WS_ROPE = 2 * MiB;
constexpr size_t WS_CAR = 4 * MiB;
constexpr size_t WS_W = 8 * MiB;
constexpr size_t W_UP1 = WS_W, W_DN1 = W_UP1 + 11 * MiB, W_IN = W_DN1 + 11 * MiB / 2, W_AO = W_IN + 11 * MiB, W_LO = W_AO + 2 * MiB, W_OUT = W_LO + 2 * MiB,
                 W_UP2 = W_OUT + 2 * MiB, W_DN2 = W_UP2 + 11 * MiB, W_LRU = W_DN2 + 11 * MiB / 2, W_END = W_LRU + 1 * MiB;
constexpr size_t WS_SW = 488 * MiB, SW_LAYER = (size_t)3 * 8 * 5632 * 4;
constexpr size_t WS_H = 60 * MiB;
constexpr size_t WS_BIG = 124 * MiB;
constexpr size_t WS_Q = WS_BIG, WS_K = WS_Q + 64 * MiB, WS_V = WS_K + 16 * MiB, WS_LX = WS_V + 16 * MiB, WS_LG = WS_LX + 64 * MiB, WS_GT = WS_LG + 64 * MiB, WS_END = WS_GT + 128 * MiB;
constexpr size_t WS_XB2 = WS_BIG + 288 * MiB;
constexpr size_t WS_ACT = WS_BIG;
static_assert(W_END <= WS_H && WS_SW + 2 * SW_LAYER <= 512 * MiB && WS_RSS + 6 * (size_t)NT_TOK * 4 <= WS_MOD && WS_XB2 + 64 * MiB <= WS_END && WS_XB2 >= WS_ACT + (size_t)NT_TOK * DFF * 2 && WS_H + 64 * MiB <= WS_BIG && WS_ACT + (size_t)NT_TOK * DFF * 2 <= WS_END && WS_END <= 512 * MiB, "ws map");
constexpr size_t WS_GRAN = 476 * MiB, GRAN_WORDS = (size_t)64 * 2 * 32 * 128 * 3;
static_assert(WS_GRAN >= WS_END && WS_GRAN + GRAN_WORDS * 8 <= WS_SW, "granules");
constexpr int LDS_MISC = 141312, LDS_BYTES = LDS_MISC + 1024;

constexpr int TC = 128, NCHK = SEQ / TC;
constexpr int XC_STRIDE = 272;
constexpr int LDS_XC = 0, LDS_HF = 34816, HF_STRIDE = 132;
constexpr int LDS_APL = LDS_HF + 128 * HF_STRIDE * 4, APL_STRIDE = 136  , LDS_HIN = LDS_APL + 128 * APL_STRIDE * 2, LDS_CW = LDS_HIN + 512;
static_assert(LDS_CW + 2560 <= LDS_MISC, "lru lds");

struct Args { const float* in[23]; float* out; unsigned char* ws; int ph_lo, ph_hi; };
typedef const Args __attribute__((address_space(4)))* ArgsP;
enum { I_X = 0, I_C, I_ADAW, I_ADAB, I_NORMG, I_UP1, I_DN1, I_WIN, I_QG, I_KG, I_CONVW, I_CONVB, I_WA, I_BA, I_WX, I_BX, I_LAM, I_WAO, I_WLO, I_WOUT, I_UP2, I_DN2, I_FING };

__device__ __forceinline__ unsigned pk2(float lo, float hi) { return pg8::cvt_pk_bf16(lo, hi); }
__device__ __forceinline__ float bflo(unsigned u) { return __uint_as_float(u << 16); }
__device__ __forceinline__ float bfhi(unsigned u) { return __uint_as_float(u & 0xffff0000u); }
__device__ __forceinline__ float sigm(float x) { return __builtin_amdgcn_rcpf(1.f + __expf(-x)); }
__device__ __forceinline__ float wave_sum(float v) {
#pragma unroll
    for (int o = 1; o < 64; o <<= 1) v += __shfl_xor(v, o);
    return v;
}
#define LDS_WAIT() asm volatile("s_waitcnt lgkmcnt(0)" ::: "memory")


typedef const float __attribute__((address_space(4)))* cfp4;
__device__ __forceinline__ float sel16(cfp4 p, int fr) {
    float t8[8], t4[4], t2[2];
#pragma unroll
    for (int i = 0; i < 8; ++i) t8[i] = (fr & 1) ? p[2 * i + 1] : p[2 * i];
#pragma unroll
    for (int i = 0; i < 4; ++i) t4[i] = (fr & 2) ? t8[2 * i + 1] : t8[2 * i];
#pragma unroll
    for (int i = 0; i < 2; ++i) t2[i] = (fr & 4) ? t4[2 * i + 1] : t4[2 * i];
    return (fr & 8) ? t2[1] : t2[0];
}
__device__ __forceinline__ float sel4x8(cfp4 p, int fq, int e) {
    const float a0 = (fq & 1) ? p[8 + e] : p[e], a1 = (fq & 1) ? p[24 + e] : p[16 + e];
    return (fq & 2) ? a1 : a0;
}
struct EpiSwiglu {
    static constexpr bool PERM = true, AFTER_DRAIN = false;
    ArgsP ap; int l, s;
    __device__ __forceinline__ void operator()(const f32x4 (&acc)[2][2][4][2], const pg8::Unit& u, int wr, int wc, int fr, int fq) const {
        unsigned char* ws = ap->ws; bf16_t* O = (bf16_t*)(ws + WS_ACT);
        const int row0 = u.pm * 256 + wr * 64 + fr, col0 = u.pn * 128 + wc * 32 + 8 * fq;
#pragma unroll
        for (int ai = 0; ai < 2; ++ai)
#pragma unroll
            for (int m = 0; m < 4; ++m) {
                bf16_t* rowp = O + (size_t)(row0 + ai * 128 + m * 16) * DFF + col0;
                float v[8];
#pragma unroll
                for (int n = 0; n < 2; ++n)
#pragma unroll
                    for (int j = 0; j < 4; ++j) { const float g = acc[ai][0][m][n][j], up = acc[ai][1][m][n][j]; v[n * 4 + j] = g * sigm(g) * up; }
                u32x4 w; w.x = pk2(v[0], v[1]); w.y = pk2(v[2], v[3]); w.z = pk2(v[4], v[5]); w.w = pk2(v[6], v[7]);
                *(u32x4*)rowp = w;
            }
    }
};
struct EpiInproj {
    static constexpr bool PERM = true, AFTER_DRAIN = false;
    ArgsP ap; int l; LAS unsigned char* lds;
    __device__ __forceinline__ void operator()(const f32x4 (&acc)[2][2][4][2], const pg8::Unit& u, int wr, int wc, int fr, int fq) const {
        unsigned char* ws = ap->ws;
        bf16_t *Q = (bf16_t*)(ws + WS_Q), *K = (bf16_t*)(ws + WS_K), *V = (bf16_t*)(ws + WS_V), *LX = (bf16_t*)(ws + WS_LX), *LG = (bf16_t*)(ws + WS_LG), *GT = (bf16_t*)(ws + WS_GT);
        const int pn = u.pn; bf16_t* base; int ld, coff; bool sg = false;
        if (pn == 4) {
            LAS float* P = (LAS float*)(lds + 131072);
            const int rl0 = wr * 64 + fr;
#pragma unroll
            for (int ai = 0; ai < 2; ++ai)
#pragma unroll
                for (int m = 0; m < 4; ++m)
#pragma unroll
                    for (int bj = 0; bj < 2; ++bj) {
                        const f32x4 a0 = acc[ai][bj][m][0], a1 = acc[ai][bj][m][1];
                        const float ssq = ((a0.x * a0.x + a0.y * a0.y) + (a0.z * a0.z + a0.w * a0.w)) + ((a1.x * a1.x + a1.y * a1.y) + (a1.z * a1.z + a1.w * a1.w));
                        const unsigned us = __float_as_uint(ssq);
                        auto r = __builtin_amdgcn_permlane32_swap(us, us, false, false);
                        const float s1 = __uint_as_float(r[0]) + __uint_as_float(r[1]);
                        auto p = __builtin_amdgcn_permlane16_swap(__float_as_uint(s1), __float_as_uint(s1), false, false);
                        const float tot = __uint_as_float(p[0]) + __uint_as_float(p[1]);
                        if (fq == 0) P[((ai * 128 + m * 16 + rl0) * 2 + bj) * 4 + wc] = tot;
                    }
            asm volatile("s_waitcnt lgkmcnt(0)" ::: "memory"); __builtin_amdgcn_s_barrier(); asm volatile("" ::: "memory");
            const float* kg = ap->in[I_KG] + l * 128 + wc * 32 + 8 * fq;
            const float* rope = (const float*)(ws + WS_ROPE) + wc * 32 + 8 * fq;
            const f32x4 kg0 = *(const f32x4*)kg, kg1 = *(const f32x4*)(kg + 4);
            const int row0k = u.pm * 256 + wr * 64 + fr;
#pragma unroll
            for (int ai = 0; ai < 2; ++ai)
#pragma unroll
                for (int m = 0; m < 4; ++m) {
                    const int row = row0k + ai * 128 + m * 16, pos = row & (SEQ - 1);
                    const f32x4 c0 = *(const f32x4*)(rope + (size_t)pos * 128), c1 = *(const f32x4*)(rope + (size_t)pos * 128 + 4);
#pragma unroll
                    for (int bj = 0; bj < 2; ++bj) {
                        const f32x4 pp = *(const LAS f32x4*)(P + ((ai * 128 + m * 16 + rl0) * 2 + bj) * 4);
                        const float rstd = rsqrtf(((pp.x + pp.y) + (pp.z + pp.w)) * (1.f / 128.f) + EPSN);
                        const f32x4 y0 = acc[ai][bj][m][0] * rstd * kg0, y1 = acc[ai][bj][m][1] * rstd * kg1;
                        u32x4 w;
                        w.x = pk2(y0.x * c0.x - y0.y * c0.y, y0.x * c0.y + y0.y * c0.x); w.y = pk2(y0.z * c0.z - y0.w * c0.w, y0.z * c0.w + y0.w * c0.z);
                        w.z = pk2(y1.x * c1.x - y1.y * c1.y, y1.x * c1.y + y1.y * c1.x); w.w = pk2(y1.z * c1.z - y1.w * c1.w, y1.z * c1.w + y1.w * c1.z);
                        *(u32x4*)(K + (size_t)row * 256 + bj * 128 + wc * 32 + 8 * fq) = w;
                    }
                }
            return;
        }
        if (pn < 4) { base = Q; ld = 1024; coff = 256 * pn; }
        else if (pn == 4) { base = K; ld = 256; coff = 0; }
        else if (pn == 5) { base = V; ld = 256; coff = 0; }
        else if (pn < 10) { base = LX; ld = 1024; coff = 256 * (pn - 6); }
        else if (pn < 14) { base = LG; ld = 1024; coff = 256 * (pn - 10); }
        else { base = GT; ld = 2048; coff = 256 * (pn - 14); sg = true; }
        const int row0 = u.pm * 256 + wr * 64 + fr, col0 = coff + wc * 32 + 8 * fq;
#pragma unroll
        for (int ai = 0; ai < 2; ++ai)
#pragma unroll
            for (int m = 0; m < 4; ++m) {
                bf16_t* rowp = base + (size_t)(row0 + ai * 128 + m * 16) * ld + col0;
#pragma unroll
                for (int bj = 0; bj < 2; ++bj) {
                    f32x4 v0 = acc[ai][bj][m][0], v1 = acc[ai][bj][m][1];
                    if (sg) {
#pragma unroll
                        for (int j = 0; j < 4; ++j) { v0[j] = sigm(v0[j]); v1[j] = sigm(v1[j]); }
                    }
                    u32x4 w; w.x = pk2(v0[0], v0[1]); w.y = pk2(v0[2], v0[3]); w.z = pk2(v1[0], v1[1]); w.w = pk2(v1[2], v1[3]);
                    *(u32x4*)(rowp + bj * 128) = w;
                }
            }
    }
};
struct EpiResid {
    static constexpr bool PERM = false, AFTER_DRAIN = false;
    ArgsP ap; int l, s, dry;
    __device__ __forceinline__ void operator()(const f32x4 (&acc_)[2][2][4][2], const pg8::Unit& u, int wr, int wc, int fr, int fq) const {
        f32x4 (&acc)[2][2][4][2] = const_cast<f32x4 (&)[2][2][4][2]>(acc_);
        unsigned char* ws = ap->ws; float* xout = ap->out; const float* xin = (s == 2 && l == 0) ? ap->in[I_X] : (const float*)xout;
        const float* mod = (const float*)(ws + WS_MOD);
        const int gi = s == 2 ? 2 : (s == 8 ? 5 : 8);
        const float* gate = mod + (size_t)l * 8 * NMODV + (size_t)gi * DM;
        const float coef = dry ? 0.f : (s == 8 ? 1.f : 0.5f);
        const int nl = s == 11 ? l + 1 : l, nn = s == 2 ? 1 : (s == 8 ? 2 : 0);
        const bool has_next = !(dry || nl > 1) && gridDim.x == 256;
        bf16_t* xb = (bf16_t*)(ws + (s == 8 ? WS_XB2 : WS_H));
        float* rss = (float*)(ws + WS_RSS) + (size_t)((nl & 1) * 3 + nn) * NT_TOK;
        const int row0 = u.pm * 256 + wr * 64 + fr, col0 = u.pn * 256 + wc * 32 + 4 * fq, b = (u.pm * 256) >> 12;
        {
            const float* gp = gate + (size_t)b * NMODV + col0;
            f32x4 gv[2][2];
#pragma unroll
            for (int bj = 0; bj < 2; ++bj)
#pragma unroll
                for (int n = 0; n < 2; ++n) gv[bj][n] = *(const f32x4*)(gp + bj * 128 + n * 16) * coef;
#pragma unroll
            for (int ai = 0; ai < 2; ++ai)
#pragma unroll
                for (int m = 0; m < 4; ++m) {
                    const size_t off = (size_t)(row0 + ai * 128 + m * 16) * DM + col0;
                    float ssq = 0.f;
#pragma unroll
                    for (int bj = 0; bj < 2; ++bj)
#pragma unroll
                        for (int n = 0; n < 2; ++n) {
                            const f32x4 xi = *(const f32x4*)(xin + off + bj * 128 + n * 16);
                            const f32x4 o = xi + gv[bj][n] * acc[ai][bj][m][n];
                            *(f32x4*)(xout + off + bj * 128 + n * 16) = o;
                            acc[ai][bj][m][n] = o;
                            ssq += (o.x * o.x + o.y * o.y) + (o.z * o.z + o.w * o.w);
                        }
                    if (has_next) {
                        const unsigned us = __float_as_uint(ssq);
                        auto r = __builtin_amdgcn_permlane32_swap(us, us, false, false);
                        const float s1 = __uint_as_float(r[0]) + __uint_as_float(r[1]);
                        auto p = __builtin_amdgcn_permlane16_swap(__float_as_uint(s1), __float_as_uint(s1), false, false);
                        const float tot = __uint_as_float(p[0]) + __uint_as_float(p[1]);
                        if (fq == 0) atomicAdd(rss + row0 + ai * 128 + m * 16, tot);
                    }
                    if (m == 3) asm volatile("" ::: "memory");
                }
        }
        if (has_next) {
            unsigned* cnt = (unsigned*)(ws + WS_CNT) + (size_t)(((nl & 1) * 3 + nn) * 128 + u.pm) * 16;
            asm volatile("s_waitcnt vmcnt(0)" ::: "memory");
            if (fr == 0 && fq == 0) __hip_atomic_fetch_add(cnt, 1u, __ATOMIC_RELAXED, __HIP_MEMORY_SCOPE_AGENT);
            for (unsigned spins = 0; (unsigned)__builtin_amdgcn_readfirstlane(__hip_atomic_load(cnt, __ATOMIC_RELAXED, __HIP_MEMORY_SCOPE_AGENT)) < 32u; ) {
                __builtin_amdgcn_s_sleep(1); if (++spins > (1u << 22)) break; }
            asm volatile("" ::: "memory");
            const float* ng = ap->in[I_NORMG] + (size_t)((nl & 1) * 3 + nn) * DM + col0;
            const float* nsc = mod + (size_t)(nl & 1) * 8 * NMODV + (size_t)b * NMODV + (size_t)(3 * nn + 1) * DM + col0;
            const float* nsh = mod + (size_t)(nl & 1) * 8 * NMODV + (size_t)b * NMODV + (size_t)(3 * nn) * DM + col0;
            f32x4 gs[2][2], sh[2][2];
#pragma unroll
            for (int bj = 0; bj < 2; ++bj)
#pragma unroll
                for (int n = 0; n < 2; ++n) { gs[bj][n] = *(const f32x4*)(ng + bj * 128 + n * 16) * (*(const f32x4*)(nsc + bj * 128 + n * 16) + 1.f); sh[bj][n] = *(const f32x4*)(nsh + bj * 128 + n * 16); }
#pragma unroll
            for (int ai = 0; ai < 2; ++ai)
#pragma unroll
                for (int m = 0; m < 4; ++m) {
                    const int row = row0 + ai * 128 + m * 16;
                    const float rs = rsqrtf(__hip_atomic_load(rss + row, __ATOMIC_RELAXED, __HIP_MEMORY_SCOPE_AGENT) * (1.f / DM) + EPSN);
                    const size_t off = (size_t)row * DM + col0;
#pragma unroll
                    for (int bj = 0; bj < 2; ++bj)
#pragma unroll
                        for (int n = 0; n < 2; ++n) { const f32x4 y = acc[ai][bj][m][n] * rs * gs[bj][n] + sh[bj][n];
                            *(u32x2*)(xb + off + bj * 128 + n * 16) = (u32x2){pk2(y.x, y.y), pk2(y.z, y.w)}; }
                }
        }
    }
};
struct EpiGate {
    static constexpr bool PERM = true, AFTER_DRAIN = false;
    ArgsP ap; int second;
    __device__ __forceinline__ void operator()(const f32x4 (&acc)[2][2][4][2], const pg8::Unit& u, int wr, int wc, int fr, int fq) const {
        unsigned char* ws = ap->ws; bf16_t* H = (bf16_t*)(ws + WS_H); const bf16_t* GT = (const bf16_t*)(ws + WS_GT);
        const int row0 = u.pm * 256 + wr * 64 + fr, col0 = u.pn * 256 + wc * 32 + 8 * fq;
#pragma unroll
        for (int ai = 0; ai < 2; ++ai)
#pragma unroll
            for (int m = 0; m < 4; ++m) {
                const size_t r = (size_t)(row0 + ai * 128 + m * 16);
#pragma unroll
                for (int bj = 0; bj < 2; ++bj) {
                    const u32x4 g = *(const u32x4*)(GT + r * 2048 + second * 1024 + col0 + bj * 128);
                    const f32x4 a0 = acc[ai][bj][m][0], a1 = acc[ai][bj][m][1];
                    float v[8] = { bflo(g.x) * a0[0], bfhi(g.x) * a0[1], bflo(g.y) * a0[2], bfhi(g.y) * a0[3], bflo(g.z) * a1[0], bfhi(g.z) * a1[1], bflo(g.w) * a1[2], bfhi(g.w) * a1[3] };
                    bf16_t* hp = H + r * DM + col0 + bj * 128;
                    if (second) { const u32x4 h = *(const u32x4*)hp;
                        v[0] += bflo(h.x); v[1] += bfhi(h.x); v[2] += bflo(h.y); v[3] += bfhi(h.y); v[4] += bflo(h.z); v[5] += bfhi(h.z); v[6] += bflo(h.w); v[7] += bfhi(h.w); }
                    u32x4 w; w.x = pk2(v[0], v[1]); w.y = pk2(v[2], v[3]); w.z = pk2(v[4], v[5]); w.w = pk2(v[6], v[7]);
                    *(u32x4*)hp = w;
                }
            }
    }
};

__device__ __forceinline__ f32x4 gemv8_block(const float* W, int ldw, int col0, const LAS float* vec, LAS float* part, int tid) {
    const int lane = tid & 63, wave = tid >> 6;
    const float* w = W + (size_t)(wave * 128) * ldw + col0 + 4 * lane;
    f32x4 acc[8];
#pragma unroll
    for (int b = 0; b < 8; ++b) acc[b] = (f32x4){0.f, 0.f, 0.f, 0.f};
#pragma unroll 1
    for (int k0 = 0; k0 < 128; k0 += 32) {
        f32x4 wv[32];
#pragma unroll
        for (int i = 0; i < 32; ++i) wv[i] = __builtin_nontemporal_load((const f32x4*)(w + (size_t)(k0 + i) * ldw));
#pragma unroll
        for (int i = 0; i < 32; ++i)
#pragma unroll
            for (int b = 0; b < 8; ++b) acc[b] += wv[i] * vec[b * DM + wave * 128 + k0 + i];
    }
#pragma unroll
    for (int b = 0; b < 8; ++b) *(LAS f32x4*)(part + ((wave * 8 + b) * 64 + lane) * 4) = acc[b];
    __syncthreads();
    f32x4 s = {0.f, 0.f, 0.f, 0.f};
#pragma unroll
    for (int w8 = 0; w8 < 8; ++w8) s += *(const LAS f32x4*)(part + ((w8 * 8 + wave) * 64 + lane) * 4);
    __syncthreads();
    return s;
}
__device__ __forceinline__ void phase_mod_rope(const Args& a, LAS unsigned char* lds) {
    const int tid = opaque_tid(), lane = tid & 63, wave = tid >> 6; int G = gridDim.x; asm volatile("" : "+s"(G));
    LAS float* sc = (LAS float*)lds;
    LAS float* part = (LAS float*)(lds + 32768);
    float* mod = (float*)(a.ws + WS_MOD);
    if (blockIdx.x < 72) {
        const float* c = a.in[I_C];
        for (int i = tid; i < NB * DM; i += NTHR) { const float v = c[i]; sc[i] = v / (1.f + __expf(-v)); }
        __syncthreads();
        for (int item = blockIdx.x; item < 72; item += G) {
            const int l = item / 36, col0 = (item % 36) * 256;
            const f32x4 s = gemv8_block(a.in[I_ADAW] + (size_t)l * DM * NMODV, NMODV, col0, sc, part, tid);
            const int col = col0 + 4 * lane;
            *(f32x4*)(mod + (size_t)(l * 8 + wave) * NMODV + col) = s + *(const f32x4*)(a.in[I_ADAB] + l * NMODV + col);
        }
    }
    { unsigned long long* gz = (unsigned long long*)(a.ws + WS_GRAN); for (size_t e = (size_t)blockIdx.x * NTHR + tid; e < GRAN_WORDS; e += (size_t)G * NTHR) gz[e] = 0ull; }
    { unsigned* cz = (unsigned*)(a.ws + WS_CNT); for (int e = blockIdx.x * NTHR + tid; e < 6 * 128 * 16; e += G * NTHR) cz[e] = 0u; }
    { float* rz = (float*)(a.ws + WS_RSS); for (int e = blockIdx.x * NTHR + tid; e < 6 * NT_TOK; e += G * NTHR) rz[e] = 0.f; }
    f32x2* rope = (f32x2*)(a.ws + WS_ROPE);
    for (int e = blockIdx.x * NTHR + tid; e < SEQ * 64; e += G * NTHR) {
        const int s = e >> 6, i = e & 63, m = i & 31;
        const float invf = powf(10000.f, -(float)(2 * m) / 64.f);
        const float pos = (float)(i < 32 ? (s >> 6) : (s & 63));
        const float ang = pos * invf;
        rope[e] = (f32x2){cosf(ang), sinf(ang)};
    }
}

__device__ __forceinline__ void transpose_item(const float* W, int K, int N, bf16_t* WT, int kb, int n0, int outrow0, LAS float* scr, int lane, float sc = 1.f) {
    const int k0 = 64 * kb;
    float wv[32];
#pragma unroll
    for (int i = 0; i < 32; ++i) { const int kk = 2 * i + (lane >> 5); wv[i] = W[(size_t)(k0 + kk) * N + n0 + (lane & 31)]; }
#pragma unroll
    for (int i = 0; i < 32; ++i) { const int kk = 2 * i + (lane >> 5); scr[kk * 33 + (lane & 31)] = wv[i]; }
    LDS_WAIT();
    const int c = lane & 7;
#pragma unroll
    for (int j = 0; j < 4; ++j) { const int n = (lane >> 3) + 8 * j; const LAS float* s = scr + (8 * c) * 33 + n;
        u32x4 o; o.x = pk2(s[0 * 33] * sc, s[1 * 33] * sc); o.y = pk2(s[2 * 33] * sc, s[3 * 33] * sc); o.z = pk2(s[4 * 33] * sc, s[5 * 33] * sc); o.w = pk2(s[6 * 33] * sc, s[7 * 33] * sc);
        *(u32x4*)(WT + (size_t)(outrow0 + n) * K + k0 + 8 * c) = o; }
    LDS_WAIT();
}
__device__ __forceinline__ void phase_convert_weights(const Args& a, int l, LAS unsigned char* lds) {
    const int tid = opaque_tid(), lane = tid & 63, wave = tid >> 6;
    LAS float* scr = (LAS float*)(lds + wave * 16384);
    const int gw = blockIdx.x * NWAVES + wave, NGW = gridDim.x * NWAVES;
    constexpr int I_UP = 16 * 176, I_DN = 44 * 32, I_SQ = 16 * 32, I_L = 256;
    constexpr int NITEMS = 3 * I_UP + 2 * I_DN + 3 * I_SQ + I_L;
    unsigned char* ws = a.ws;
    for (int it = gw; it < NITEMS; it += NGW) {
        int r = it;
        if (r < 2 * I_UP) {
            const int which = r / I_UP; r -= which * I_UP;
            const float* W = a.in[which ? I_UP2 : I_UP1] + (size_t)l * DM * NUP; bf16_t* WT = (bf16_t*)(ws + (which ? W_UP2 : W_UP1));
            const int kb = r / 176, n0 = (r % 176) * 32, half = n0 / DFF, j = n0 % DFF;
            transpose_item(W, DM, NUP, WT, kb, n0, 256 * (j / 128) + 128 * half + (j % 128), scr, lane); continue; }
        r -= 2 * I_UP;
        if (r < I_UP) { const int kb = r / 176, n0 = (r % 176) * 32;
            transpose_item(a.in[I_WIN] + (size_t)l * DM * INC, DM, INC, (bf16_t*)(ws + W_IN), kb, n0, n0, scr, lane); continue; }
        r -= I_UP;
        if (r < 2 * I_DN) { const int which = r / I_DN; r -= which * I_DN;
            const int kb = r / 32, n0 = (r % 32) * 32;
            transpose_item(a.in[which ? I_DN2 : I_DN1] + (size_t)l * DFF * DM, DFF, DM, (bf16_t*)(ws + (which ? W_DN2 : W_DN1)), kb, n0, n0, scr, lane); continue; }
        r -= 2 * I_DN;
        if (r < 3 * I_SQ) { const int which = r / I_SQ; r -= which * I_SQ;
            const int kb = r / 32, n0 = (r % 32) * 32;
            const float* W = a.in[which == 0 ? I_WAO : (which == 1 ? I_WLO : I_WOUT)] + (size_t)l * DM * DM;
            bf16_t* WT = (bf16_t*)(ws + (which == 0 ? W_AO : (which == 1 ? W_LO : W_OUT)));
            transpose_item(W, DM, DM, WT, kb, n0, n0, scr, lane); continue; }
        r -= 3 * I_SQ;
        {
            const int mat = r >> 3, sub = r & 7, kb = sub >> 2, n0 = (sub & 3) * 32;
            const int type = mat & 1, d = (mat >> 1) & 1, hb = mat >> 2;
            const float* W = a.in[type ? I_WX : I_WA] + (size_t)(((l * 2 + d) * 8 + hb)) * 128 * 128;
            bf16_t* WT = (bf16_t*)(ws + W_LRU) + (size_t)((hb * 2 + d) * 2 + type) * 128 * 128;
            transpose_item(W, 128, 128, WT, kb, n0, n0, scr, lane, -1.4426950408889634f);
        }
    }
}


__device__ __forceinline__ void phase_sw(const Args& a, int l, LAS unsigned char* lds) {
    const int tid = opaque_tid(), lane = tid & 63, wave = tid >> 6, G = gridDim.x;
    LAS float* sh = (LAS float*)lds;
    LAS float* part = (LAS float*)(lds + 32768);
    const float* modl = (const float*)(a.ws + WS_MOD) + (size_t)l * 8 * NMODV;
    float* SW = (float*)(a.ws + WS_SW + (size_t)l * SW_LAYER);
    for (int item = blockIdx.x; item < 66; item += G) {
        const int mm = item / 22, col0 = (item % 22) * 256;
        for (int i = tid; i < NB * DM; i += NTHR) { const int b = i >> 10, k = i & 1023; sh[i] = modl[(size_t)(b * 9 + 3 * mm) * DM + k]; }
        __syncthreads();
        const f32x4 s = gemv8_block(a.in[mm == 0 ? I_UP1 : (mm == 1 ? I_WIN : I_UP2)] + (size_t)l * DM * INC, INC, col0, sh, part, tid);
        const int col = col0 + 4 * lane; int np = col;
        if (mm != 1) { const int half = col / DFF, j = col % DFF; np = 256 * (j / 128) + 128 * half + (j % 128); }
        *(f32x4*)(SW + (size_t)(mm * 8 + wave) * INC + np) = s;
    }
}

__device__ __forceinline__ void phase_norm(const float* xin, const float* g, const float* modl, int ishift, int iscale, bf16_t* H) {
    const int tid = opaque_tid(), lane = tid & 63, wave = tid >> 6;
    const int gw = blockIdx.x * NWAVES + wave, NGW = gridDim.x * NWAVES;
    f32x4 v[4], vn[4];
    if (gw < NT_TOK) {
#pragma unroll
        for (int j = 0; j < 4; ++j) v[j] = ((const f32x4*)(xin + (size_t)gw * DM) + lane)[64 * j];
    }
    for (int m = gw; m < NT_TOK; m += NGW) {
        const int b = m >> 12, mn = m + NGW;
        if (mn < NT_TOK) {
#pragma unroll
            for (int j = 0; j < 4; ++j) vn[j] = ((const f32x4*)(xin + (size_t)mn * DM) + lane)[64 * j];
        }
        const f32x4* gr = (const f32x4*)g + lane;
        const f32x4* shr = (const f32x4*)(modl + (size_t)(b * 9 + ishift) * DM) + lane;
        const f32x4* scr = (const f32x4*)(modl + (size_t)(b * 9 + iscale) * DM) + lane;
        float s = 0.f;
#pragma unroll
        for (int j = 0; j < 4; ++j) s += (v[j].x * v[j].x + v[j].y * v[j].y) + (v[j].z * v[j].z + v[j].w * v[j].w);
        const float rstd = rsqrtf(wave_sum(s) * (1.f / DM) + EPSN);
        u32x2* o8 = (u32x2*)(H + (size_t)m * DM) + lane;
#pragma unroll
        for (int j = 0; j < 4; ++j) { const f32x4 gg = gr[64 * j], sh = shr[64 * j], sl = scr[64 * j];
            const f32x4 y = v[j] * rstd * gg * (sl + 1.f) + sh;
            o8[64 * j] = (u32x2){pk2(y.x, y.y), pk2(y.z, y.w)}; }
#pragma unroll
        for (int j = 0; j < 4; ++j) v[j] = vn[j];
    }
}
__device__ __forceinline__ void phase_final_norm(float* x, const float* g) {
    const int tid = opaque_tid(), lane = tid & 63, wave = tid >> 6;
    const int gw = blockIdx.x * NWAVES + wave, NGW = gridDim.x * NWAVES;
    f32x4 v[4], vn[4];
    if (gw < NT_TOK) {
#pragma unroll
        for (int j = 0; j < 4; ++j) v[j] = ((const f32x4*)(x + (size_t)gw * DM) + lane)[64 * j];
    }
    for (int m = gw; m < NT_TOK; m += NGW) {
        const int mn = m + NGW;
        if (mn < NT_TOK) {
#pragma unroll
            for (int j = 0; j < 4; ++j) vn[j] = ((const f32x4*)(x + (size_t)mn * DM) + lane)[64 * j];
        }
        f32x4* xr = (f32x4*)(x + (size_t)m * DM) + lane; const f32x4* gr = (const f32x4*)g + lane;
        float s = 0.f;
#pragma unroll
        for (int j = 0; j < 4; ++j) s += (v[j].x * v[j].x + v[j].y * v[j].y) + (v[j].z * v[j].z + v[j].w * v[j].w);
        const float rstd = rsqrtf(wave_sum(s) * (1.f / DM) + EPSN);
#pragma unroll
        for (int j = 0; j < 4; ++j) xr[64 * j] = v[j] * rstd * gr[64 * j];
#pragma unroll
        for (int j = 0; j < 4; ++j) v[j] = vn[j];
    }
}
__device__ __forceinline__ void phase_qk(bf16_t* K, const float* kg, const f32x2* rope) {
    const int tid = opaque_tid(), lane = tid & 63, wave = tid >> 6;
    const int gw = blockIdx.x * NWAVES + wave, NGW = gridDim.x * NWAVES;
    const int d0 = (lane & 31) * 4;
    const f32x4 kgv = *(const f32x4*)(kg + d0);
    for (int m0 = gw; m0 < NT_TOK; m0 += 4 * NGW) {
        u32x2 r0[4]; f32x4 cs[4];
#pragma unroll
        for (int i = 0; i < 4; ++i) { const int m = m0 + i * NGW;
            if (m < NT_TOK) { r0[i] = *(const u32x2*)(K + (size_t)m * 256 + lane * 4); cs[i] = *(const f32x4*)((const float*)(rope + (size_t)(m & (SEQ - 1)) * 64 + (d0 >> 1))); } }
#pragma unroll
        for (int i = 0; i < 4; ++i) { const int m = m0 + i * NGW;
            if (m < NT_TOK) {
                const float x[4] = { bflo(r0[i].x), bfhi(r0[i].x), bflo(r0[i].y), bfhi(r0[i].y) };
                float ss = (x[0] * x[0] + x[1] * x[1]) + (x[2] * x[2] + x[3] * x[3]);
                ss += __shfl_xor(ss, 1); ss += __shfl_xor(ss, 2); ss += __shfl_xor(ss, 4); ss += __shfl_xor(ss, 8); ss += __shfl_xor(ss, 16);
                const float rstd = rsqrtf(ss * (1.f / 128.f) + EPSN);
                const float y0 = x[0] * rstd * kgv.x, y1 = x[1] * rstd * kgv.y, y2 = x[2] * rstd * kgv.z, y3 = x[3] * rstd * kgv.w;
                *(u32x2*)(K + (size_t)m * 256 + lane * 4) = (u32x2){pk2(y0 * cs[i].x - y1 * cs[i].y, y0 * cs[i].y + y1 * cs[i].x), pk2(y2 * cs[i].z - y3 * cs[i].w, y2 * cs[i].w + y3 * cs[i].z)};
            } }
    }
}


__device__ __forceinline__ float xlane16(float v, int d, int q) {
    const unsigned u = __float_as_uint(v);
    auto p = __builtin_amdgcn_permlane16_swap(u, u, false, false);
    if (d == 0) { auto t = __builtin_amdgcn_permlane32_swap(p[1], p[1], false, false);
                  return __uint_as_float((q & 1) ? p[0] : t[0]); }
    else        { auto t = __builtin_amdgcn_permlane32_swap(p[0], p[0], false, false);
                  return __uint_as_float((q & 1) ? t[1] : p[1]); }
}
__device__ __forceinline__ float xlane32(float v, int d) {
    const unsigned u = __float_as_uint(v);
    auto r = __builtin_amdgcn_permlane32_swap(u, u, false, false);
    return __uint_as_float(d == 0 ? r[0] : r[1]);
}
__device__ __forceinline__ float xlast(float v, int d) {
    const unsigned u = __float_as_uint(v);
    auto r = __builtin_amdgcn_permlane32_swap(u, u, false, false);
    const unsigned w = d == 0 ? r[1] : r[0];
    auto t = __builtin_amdgcn_permlane16_swap(w, w, false, false);
    return __uint_as_float(d == 0 ? t[1] : t[0]);
}
template <int MODE>
__device__ __forceinline__ void phase_lru(const Args& a, int l, LAS unsigned char* lds, bf16_t* LOUT) {
    const int tid = opaque_tid(), lane = tid & 63, wave = tid >> 6, cl = lane & 15, q = lane >> 4, G = gridDim.x;
    const bf16_t* LX = (const bf16_t*)(a.ws + WS_LX); const bf16_t* LG = (const bf16_t*)(a.ws + WS_LG);
    const bf16_t* WL = (const bf16_t*)(a.ws + W_LRU);
    f32x2* CAR = (f32x2*)(a.ws + WS_CAR);
    LAS float* hf = (LAS float*)(lds + LDS_HF);
    const int rt = tid >> 4, cgp = tid & 15;
    for (int it = blockIdx.x; it < NB * NCHK * 8; it += G) {
        const int hb = it & 7, bc = it >> 3, b = bc >> 5, c = bc & 31;
        const int chw = hb * 128 + wave * 16 + cl;
        {
            const int chb = hb * 128 + cgp * 8;
            float w[4][8], bias[8];
#pragma unroll
            for (int j = 0; j < 4; ++j) { const f32x4 w0 = *(const f32x4*)(a.in[I_CONVW] + (size_t)(l * 4 + j) * DM + chb), w1 = *(const f32x4*)(a.in[I_CONVW] + (size_t)(l * 4 + j) * DM + chb + 4);
                w[j][0] = w0.x; w[j][1] = w0.y; w[j][2] = w0.z; w[j][3] = w0.w; w[j][4] = w1.x; w[j][5] = w1.y; w[j][6] = w1.z; w[j][7] = w1.w; }
            { const f32x4 b0 = *(const f32x4*)(a.in[I_CONVB] + (size_t)l * DM + chb), b1 = *(const f32x4*)(a.in[I_CONVB] + (size_t)l * DM + chb + 4);
              bias[0] = b0.x; bias[1] = b0.y; bias[2] = b0.z; bias[3] = b0.w; bias[4] = b1.x; bias[5] = b1.y; bias[6] = b1.z; bias[7] = b1.w; }
            u32x4 raw[7];
#pragma unroll
            for (int i = 0; i < 7; ++i) { const int s = c * TC + 4 * rt - 2 + i;
                raw[i] = (s >= 0 && s < SEQ) ? *(const u32x4*)(LX + (size_t)(b * SEQ + s) * DM + chb) : (u32x4){0u, 0u, 0u, 0u}; }
#pragma unroll
            for (int o = 0; o < 4; ++o) {
                float y[8];
#pragma unroll
                for (int e = 0; e < 8; ++e) y[e] = bias[e];
#pragma unroll
                for (int j = 0; j < 4; ++j) { const u32x4 r = raw[o + j];
                    y[0] += bflo(r.x) * w[j][0]; y[1] += bfhi(r.x) * w[j][1]; y[2] += bflo(r.y) * w[j][2]; y[3] += bfhi(r.y) * w[j][3];
                    y[4] += bflo(r.z) * w[j][4]; y[5] += bfhi(r.z) * w[j][5]; y[6] += bflo(r.w) * w[j][6]; y[7] += bfhi(r.w) * w[j][7]; }
                *(LAS u32x4*)(lds + LDS_XC + (4 * rt + o) * XC_STRIDE + cgp * 16) = (u32x4){pk2(y[0], y[1]), pk2(y[2], y[3]), pk2(y[4], y[5]), pk2(y[6], y[7])};
            }
        }
        __syncthreads();
#pragma unroll 1
        for (int d = 0; d < 2; ++d) {
            bf16x8 wf[2][4];
#pragma unroll
            for (int ty = 0; ty < 2; ++ty)
#pragma unroll
                for (int ks = 0; ks < 4; ++ks)
                    wf[ty][ks] = *(const bf16x8*)(WL + (size_t)((hb * 2 + d) * 2 + ty) * 16384 + (wave * 16 + cl) * 128 + ks * 32 + q * 8);
            const float ba = a.in[I_BA][(l * 2 + d) * DM + chw], bx = a.in[I_BX][(l * 2 + d) * DM + chw];
            const float sp8 = -8.f * 1.4426950408889634f * log1pf(__expf(-a.in[I_LAM][(l * 2 + d) * DM + chw]));
            float hc = 0.f, lsum = 0.f;
            if (MODE == 1) {
                const f32x2* cp = CAR + (size_t)((b * 2 + d) * NCHK) * DM + chw;
#pragma unroll
                for (int g8 = 0; g8 < NCHK / 8; ++g8) {
                    f32x2 cv[8];
#pragma unroll
                    for (int e = 0; e < 8; ++e) { const int cc = d == 0 ? g8 * 8 + e : NCHK - 1 - (g8 * 8 + e); cv[e] = cp[(size_t)cc * DM]; }
#pragma unroll
                    for (int e = 0; e < 8; ++e) { const int cc = d == 0 ? g8 * 8 + e : NCHK - 1 - (g8 * 8 + e); const bool on = d == 0 ? cc < c : cc > c;
                        hc = (on ? cv[e].x : 1.f) * hc + (on ? cv[e].y : 0.f); }
                }
            }
            const int pos = d == 0 ? q : 3 - q;
#pragma unroll 1
            for (int hf4 = 0; hf4 < 2; ++hf4) {
                float av[4][4], uv[4][4], A4[4], H4[4];
#pragma unroll
                for (int mi = 0; mi < 4; ++mi) {
                    const int mt = d == 0 ? hf4 * 4 + mi : 7 - (hf4 * 4 + mi);
                    f32x4 accr = {0.f, 0.f, 0.f, 0.f}, acci = {0.f, 0.f, 0.f, 0.f};
#pragma unroll
                    for (int ks = 0; ks < 4; ++ks) {
                        const bf16x8 af = *(const LAS bf16x8*)(lds + LDS_XC + (mt * 16 + cl) * XC_STRIDE + ks * 64 + q * 16);
                        accr = __builtin_amdgcn_mfma_f32_16x16x32_bf16(af, wf[0][ks], accr, 0, 0, 0);
                        acci = __builtin_amdgcn_mfma_f32_16x16x32_bf16(af, wf[1][ks], acci, 0, 0, 0);
                    }
#pragma unroll
                    for (int j = 0; j < 4; ++j) {
                        const float xv = __uint_as_float((unsigned)(*(const LAS unsigned short*)(lds + LDS_XC + (mt * 16 + 4 * q + j) * XC_STRIDE + (wave * 16 + cl) * 2)) << 16);
                        const float rg = sigm(accr[j] + ba), ig = sigm(acci[j] + bx);
                        const float la = rg * sp8;
                        const float aa = __builtin_amdgcn_exp2f(la);
                        av[mi][j] = aa; uv[mi][j] = __builtin_amdgcn_sqrtf(fmaxf(1.f - aa * aa, 0.f)) * (ig * xv);
                        if (MODE == 0) lsum += la;
                    }
                    A4[mi] = (av[mi][0] * av[mi][1]) * (av[mi][2] * av[mi][3]);
                    if (d == 0) H4[mi] = ((uv[mi][0] * av[mi][1] + uv[mi][1]) * av[mi][2] + uv[mi][2]) * av[mi][3] + uv[mi][3];
                    else        H4[mi] = ((uv[mi][3] * av[mi][2] + uv[mi][2]) * av[mi][1] + uv[mi][1]) * av[mi][0] + uv[mi][0];
                }
                float Ae[4], He[4], At[4], Ht[4];
#pragma unroll
                for (int mi = 0; mi < 4; ++mi) {
                    { const float A1 = xlane16(A4[mi], d, q), H1 = xlane16(H4[mi], d, q); if (pos >= 1) { H4[mi] = A4[mi] * H1 + H4[mi]; A4[mi] = A4[mi] * A1; } }
                    { const float A2 = xlane32(A4[mi], d), H2 = xlane32(H4[mi], d); if (pos >= 2) { H4[mi] = A4[mi] * H2 + H4[mi]; A4[mi] = A4[mi] * A2; } }
                    Ae[mi] = xlane16(A4[mi], d, q); He[mi] = xlane16(H4[mi], d, q);
                    if (pos == 0) { Ae[mi] = 1.f; He[mi] = 0.f; }
                    At[mi] = xlast(A4[mi], d); Ht[mi] = xlast(H4[mi], d);
                }
#pragma unroll
                for (int mi = 0; mi < 4; ++mi) {
                    const int mt = d == 0 ? hf4 * 4 + mi : 7 - (hf4 * 4 + mi);
                    if (MODE == 1) {
                        float h = Ae[mi] * hc + He[mi];
                        if (d == 0) {
#pragma unroll
                            for (int j = 0; j < 4; ++j) { h = av[mi][j] * h + uv[mi][j]; hf[(mt * 16 + 4 * q + j) * HF_STRIDE + wave * 16 + cl] = h; }
                        } else {
#pragma unroll
                            for (int j = 3; j >= 0; --j) { h = av[mi][j] * h + uv[mi][j]; hf[(mt * 16 + 4 * q + j) * HF_STRIDE + wave * 16 + cl] += h; }
                        }
                    }
                    hc = At[mi] * hc + Ht[mi];
                }
            }
            if (MODE == 0) {
                lsum += __shfl_xor(lsum, 16); lsum += __shfl_xor(lsum, 32);
                if (q == 0) CAR[(size_t)((b * 2 + d) * NCHK + c) * DM + chw] = (f32x2){__builtin_amdgcn_exp2f(lsum), hc};
            }
        }
        __syncthreads();
        if (MODE == 1) {
#pragma unroll
            for (int o = 0; o < 4; ++o) {
                const int r = 4 * rt + o;
                const f32x4 h0 = *(const LAS f32x4*)(hf + r * HF_STRIDE + cgp * 8), h1 = *(const LAS f32x4*)(hf + r * HF_STRIDE + cgp * 8 + 4);
                const u32x4* gp = (const u32x4*)(LG + (size_t)(b * SEQ + c * TC + r) * DM + hb * 128 + cgp * 8);
                const u32x4 g = *gp;
                float x[8] = { bflo(g.x), bfhi(g.x), bflo(g.y), bfhi(g.y), bflo(g.z), bfhi(g.z), bflo(g.w), bfhi(g.w) };
                const float hh[8] = { h0.x, h0.y, h0.z, h0.w, h1.x, h1.y, h1.z, h1.w };
                float y[8];
#pragma unroll
                for (int e = 0; e < 8; ++e) { const float v = x[e]; const float t = 1.5957691216057308f * (v + 0.044715f * v * v * v); y[e] = hh[e] * (v * sigm(t)); }
                *(u32x4*)(LOUT + (size_t)(b * SEQ + c * TC + r) * DM + hb * 128 + cgp * 8) = (u32x4){pk2(y[0], y[1]), pk2(y[2], y[3]), pk2(y[4], y[5]), pk2(y[6], y[7])};
            }
            __syncthreads();
        }
    }
}


__device__ __forceinline__ float gran_wait(const unsigned long long* g, unsigned tag) {
    unsigned long long v; unsigned spins = 0;
    for (;;) { v = __hip_atomic_load(g, __ATOMIC_RELAXED, __HIP_MEMORY_SCOPE_AGENT); if ((unsigned)(v >> 32) == tag) break; __builtin_amdgcn_s_sleep(1); if (++spins > (1u << 22)) break; }
    return __uint_as_float((unsigned)v);
}
__device__ __forceinline__ void gran_put(unsigned long long* g, unsigned tag, float v) {
    __hip_atomic_store(g, ((unsigned long long)tag << 32) | (unsigned long long)__float_as_uint(v), __ATOMIC_RELAXED, __HIP_MEMORY_SCOPE_AGENT);
}
template <int D>
__device__ __forceinline__ void lru_chain_pass(const Args& a, int l, LAS unsigned char* lds, int chain, int j) {
    const int tid = opaque_tid(), lane = tid & 63, wave = tid >> 6, cl = lane & 15, q = lane >> 4;
    const int b = chain >> 3, hb = chain & 7, jj = D == 1 ? 3 - j : j;
    const bf16_t* LX = (const bf16_t*)(a.ws + WS_LX); bf16_t* LG = (bf16_t*)(a.ws + WS_LG); bf16_t* HB = (bf16_t*)(a.ws + WS_H);
    const bf16_t* WL = (const bf16_t*)(a.ws + W_LRU);
    LAS float* hf = (LAS float*)(lds + LDS_HF); LAS float* hin_s = (LAS float*)(lds + LDS_HIN); LAS float* cw = (LAS float*)(lds + LDS_CW);
    const int rt = tid >> 4, cgp = tid & 15;
    const int chl = wave * 16 + cl, chw = hb * 128 + chl, chb = hb * 128 + cgp * 8;
    for (int i = tid; i < 640; i += NTHR) { const int row = i >> 7, ch = i & 127; cw[i] = row < 4 ? a.in[I_CONVW][(size_t)(l * 4 + row) * DM + hb * 128 + ch] : a.in[I_CONVB][(size_t)l * DM + hb * 128 + ch]; }
    bf16x8 wf[2][4];
#pragma unroll
    for (int ty = 0; ty < 2; ++ty)
#pragma unroll
        for (int ks = 0; ks < 4; ++ks)
            wf[ty][ks] = *(const bf16x8*)(WL + (size_t)((hb * 2 + D) * 2 + ty) * 16384 + chl * 128 + ks * 32 + q * 8);
    const float ba = -1.4426950408889634f * a.in[I_BA][(l * 2 + D) * DM + chw], bx = -1.4426950408889634f * a.in[I_BX][(l * 2 + D) * DM + chw];
    const f32x4 ba4 = {ba, ba, ba, ba}, bx4 = {bx, bx, bx, bx};
    const float sp8 = -8.f * 1.4426950408889634f * log1pf(__expf(-a.in[I_LAM][(l * 2 + D) * DM + chw]));
    const int pos = D == 0 ? q : 3 - q;
    const int ak1 = (((D == 0 ? lane - 16 : lane + 16) & 63) << 2), ak2 = (((D == 0 ? lane - 32 : lane + 32) & 63) << 2), ak3 = (((D == 0 ? lane - 48 : lane + 48) & 63) << 2);
    const bool c1 = pos >= 1, c2 = pos >= 2, c3 = pos >= 3;
#define BPERM(ad, v) __int_as_float(__builtin_amdgcn_ds_bpermute((ad), __float_as_int(v)))
    const unsigned tag = (unsigned)l + 1u;
    unsigned long long* gb = (unsigned long long*)(a.ws + WS_GRAN) + (size_t)((chain * 2 + D) * 32) * 384 + (size_t)chl * 3;
#define LRU_CHUNK(r) (D == 1 ? 4 * (7 - (r)) + j : 4 * (r) + j)
#define LRU_LOAD_RAW(cc) do { _Pragma("unroll") for (int i = 0; i < 7; ++i) { const int s = (cc) * TC + 4 * rt - 2 + i; \
        raw[i] = (s >= 0 && s < SEQ) ? *(const u32x4*)(LX + (size_t)(b * SEQ + s) * DM + chb) : (u32x4){0u, 0u, 0u, 0u}; } } while (0)
    u32x4 raw[7];
    LRU_LOAD_RAW(LRU_CHUNK(0));
    __syncthreads();
#pragma unroll 1
    for (int r = 0; r < 8; ++r) {
        const int c = LRU_CHUNK(r);
        const int xco = (r & 1) ? LDS_APL : LDS_XC;
        {
            float y[4][8];
            { const f32x4 b0 = *(const LAS f32x4*)(cw + 512 + cgp * 8), b1 = *(const LAS f32x4*)(cw + 512 + cgp * 8 + 4);
#pragma unroll
              for (int o = 0; o < 4; ++o) { y[o][0] = b0.x; y[o][1] = b0.y; y[o][2] = b0.z; y[o][3] = b0.w; y[o][4] = b1.x; y[o][5] = b1.y; y[o][6] = b1.z; y[o][7] = b1.w; } }
#pragma unroll
            for (int jt = 0; jt < 4; ++jt) {
                const f32x4 w0 = *(const LAS f32x4*)(cw + jt * 128 + cgp * 8), w1 = *(const LAS f32x4*)(cw + jt * 128 + cgp * 8 + 4);
#pragma unroll
                for (int o = 0; o < 4; ++o) { const u32x4 rr = raw[o + jt];
                    y[o][0] += bflo(rr.x) * w0.x; y[o][1] += bfhi(rr.x) * w0.y; y[o][2] += bflo(rr.y) * w0.z; y[o][3] += bfhi(rr.y) * w0.w;
                    y[o][4] += bflo(rr.z) * w1.x; y[o][5] += bfhi(rr.z) * w1.y; y[o][6] += bflo(rr.w) * w1.z; y[o][7] += bfhi(rr.w) * w1.w; }
            }
#pragma unroll
            for (int o = 0; o < 4; ++o)
                *(LAS u32x4*)(lds + xco + (4 * rt + o) * XC_STRIDE + cgp * 16) = (u32x4){pk2(y[o][0], y[o][1]), pk2(y[o][2], y[o][3]), pk2(y[o][4], y[o][5]), pk2(y[o][6], y[o][7])};
        }
        __syncthreads();
        if (r + 1 < 8) LRU_LOAD_RAW(LRU_CHUNK(r + 1));
        u32x4 pg[4], ph[4];
        if (D == 0) {
#pragma unroll
            for (int o = 0; o < 4; ++o) { const size_t goff = (size_t)(b * SEQ + c * TC + o * 32 + (lane >> 1)) * DM + hb * 128 + wave * 16 + (lane & 1) * 8; pg[o] = *(const u32x4*)(LG + goff); ph[o] = *(const u32x4*)(HB + goff); }
        }
        float hc = 0.f, Ac = 1.f;
#pragma unroll 1
        for (int hf4 = 0; hf4 < 2; ++hf4) {
            float av[4][4], uv[4][4], A4[4], H4[4];
#pragma unroll
            for (int mi = 0; mi < 4; ++mi) {
                const int mt = D == 0 ? hf4 * 4 + mi : 7 - (hf4 * 4 + mi);
                f32x4 accr, acci;
#pragma unroll
                for (int ks = 0; ks < 4; ++ks) {
                    const bf16x8 af = *(const LAS bf16x8*)(lds + xco + (mt * 16 + cl) * XC_STRIDE + ks * 64 + q * 16);
                    accr = __builtin_amdgcn_mfma_f32_16x16x32_bf16(af, wf[0][ks], ks == 0 ? ba4 : accr, 0, 0, 0);
                    acci = __builtin_amdgcn_mfma_f32_16x16x32_bf16(af, wf[1][ks], ks == 0 ? bx4 : acci, 0, 0, 0);
                }
#pragma unroll
                for (int jx = 0; jx < 4; ++jx) {
                    const float xv = __uint_as_float((unsigned)(*(const LAS unsigned short*)(lds + xco + (mt * 16 + 4 * q + jx) * XC_STRIDE + chl * 2)) << 16);
                    const float rg = __builtin_amdgcn_rcpf(1.f + __builtin_amdgcn_exp2f(accr[jx])), ig = __builtin_amdgcn_rcpf(1.f + __builtin_amdgcn_exp2f(acci[jx]));
                    const float aa = __builtin_amdgcn_exp2f(rg * sp8);
                    av[mi][jx] = aa; uv[mi][jx] = __builtin_amdgcn_sqrtf(fmaf(-aa, aa, 1.f)) * (ig * xv);
                }
                A4[mi] = (av[mi][0] * av[mi][1]) * (av[mi][2] * av[mi][3]);
                if (D == 0) H4[mi] = ((uv[mi][0] * av[mi][1] + uv[mi][1]) * av[mi][2] + uv[mi][2]) * av[mi][3] + uv[mi][3];
                else        H4[mi] = ((uv[mi][3] * av[mi][2] + uv[mi][2]) * av[mi][1] + uv[mi][1]) * av[mi][0] + uv[mi][0];
            }
            float Ae[4], He[4], At[4], Ht[4];
#pragma unroll
            for (int mi = 0; mi < 4; ++mi) {
                const float A1 = BPERM(ak1, A4[mi]), H1 = BPERM(ak1, H4[mi]), A2 = BPERM(ak2, A4[mi]), H2 = BPERM(ak2, H4[mi]), A3 = BPERM(ak3, A4[mi]), H3 = BPERM(ak3, H4[mi]);
                float eA = c3 ? A3 : 1.f, eH = c3 ? H3 : 0.f;
                { const float a = c2 ? A2 : 1.f, h = c2 ? H2 : 0.f; eH = a * eH + h; eA = a * eA; }
                { const float a = c1 ? A1 : 1.f, h = c1 ? H1 : 0.f; eH = a * eH + h; eA = a * eA; }
                Ae[mi] = eA; He[mi] = eH;
                float tA = A4[mi] * eA, tH = A4[mi] * eH + H4[mi];
                { const float a = c3 ? 1.f : A3, h = c3 ? 0.f : H3; tH = a * tH + h; tA = a * tA; }
                { const float a = c2 ? 1.f : A2, h = c2 ? 0.f : H2; tH = a * tH + h; tA = a * tA; }
                { const float a = c1 ? 1.f : A1, h = c1 ? 0.f : H1; tH = a * tH + h; tA = a * tA; }
                At[mi] = tA; Ht[mi] = tH;
            }
#pragma unroll
            for (int mi = 0; mi < 4; ++mi) {
                const int mt = D == 0 ? hf4 * 4 + mi : 7 - (hf4 * 4 + mi);
                float h = Ae[mi] * hc + He[mi], ap = Ac * Ae[mi];
#pragma unroll
                for (int jx = 0; jx < 4; ++jx) { const int jt = D == 0 ? jx : 3 - jx; const int t = mt * 16 + 4 * q + jt;
                    h = av[mi][jt] * h + uv[mi][jt]; ap = ap * av[mi][jt];
                    ((LAS unsigned*)hf)[t * HF_STRIDE + chl] = pk2(h, ap); }
                hc = At[mi] * hc + Ht[mi]; Ac = Ac * At[mi];
            }
        }
        if (q == 0) {
            const int rho = 4 * r + jj;
            if (jj < 3) { gran_put(gb + (size_t)rho * 384 + 1, tag, Ac); gran_put(gb + (size_t)rho * 384 + 2, tag, hc); }
            float hin = 0.f;
            if (r > 0) hin = gran_wait(gb + (size_t)(4 * r - 1) * 384, tag);
            for (int k = 0; k < jj; ++k) { const float A = gran_wait(gb + (size_t)(4 * r + k) * 384 + 1, tag), H = gran_wait(gb + (size_t)(4 * r + k) * 384 + 2, tag); hin = A * hin + H; }
            if (jj == 3) gran_put(gb + (size_t)rho * 384, tag, Ac * hin + hc);
            hin_s[chl] = hin;
        }
        asm volatile("s_waitcnt lgkmcnt(0)" ::: "memory");
#pragma unroll
        for (int o = 0; o < 4; ++o) {
            const int rr = o * 32 + (lane >> 1), cb8 = wave * 16 + (lane & 1) * 8;
            const u32x4 w0 = *(const LAS u32x4*)((const LAS unsigned*)hf + rr * HF_STRIDE + cb8), w1 = *(const LAS u32x4*)((const LAS unsigned*)hf + rr * HF_STRIDE + cb8 + 4);
            const f32x4 i0 = *(const LAS f32x4*)(hin_s + cb8), i1 = *(const LAS f32x4*)(hin_s + cb8 + 4);
            float hh[8] = { bflo(w0.x) + bfhi(w0.x) * i0.x, bflo(w0.y) + bfhi(w0.y) * i0.y, bflo(w0.z) + bfhi(w0.z) * i0.z, bflo(w0.w) + bfhi(w0.w) * i0.w,
                            bflo(w1.x) + bfhi(w1.x) * i1.x, bflo(w1.y) + bfhi(w1.y) * i1.y, bflo(w1.z) + bfhi(w1.z) * i1.z, bflo(w1.w) + bfhi(w1.w) * i1.w };
            const size_t goff = (size_t)(b * SEQ + c * TC + rr) * DM + hb * 128 + cb8;
            if (D == 1) {
                *(u32x4*)(HB + goff) = (u32x4){pk2(hh[0], hh[1]), pk2(hh[2], hh[3]), pk2(hh[4], hh[5]), pk2(hh[6], hh[7])};
            } else {
                const u32x4 g = pg[o], hbv = ph[o];
                const float x[8] = { bflo(g.x), bfhi(g.x), bflo(g.y), bfhi(g.y), bflo(g.z), bfhi(g.z), bflo(g.w), bfhi(g.w) };
                const float hb8[8] = { bflo(hbv.x), bfhi(hbv.x), bflo(hbv.y), bfhi(hbv.y), bflo(hbv.z), bfhi(hbv.z), bflo(hbv.w), bfhi(hbv.w) };
                float yy[8];
#pragma unroll
                for (int e = 0; e < 8; ++e) { const float v = x[e]; const float t = 1.5957691216057308f * (v + 0.044715f * v * v * v); yy[e] = (hh[e] + hb8[e]) * (v * sigm(t)); }
                *(u32x4*)(LG + goff) = (u32x4){pk2(yy[0], yy[1]), pk2(yy[2], yy[3]), pk2(yy[4], yy[5]), pk2(yy[6], yy[7])};
            }
        }
    }
    __syncthreads();
#undef LRU_CHUNK
#undef LRU_LOAD_RAW
#undef BPERM
}
__device__ __forceinline__ void phase_lru_chain(const Args& a, int l, LAS unsigned char* lds) {
    if (gridDim.x != 256) return;
    const int bx = blockIdx.x, chain = bx & 63, j = bx >> 6;
    lru_chain_pass<1>(a, l, lds, chain, j);
    lru_chain_pass<0>(a, l, lds, chain, j);
}

#ifndef PROBE
#define PROBE 0
#endif
__host__ __device__ constexpr int probe_dup(int s) {
    return (((PROBE & 1) && (s == 1 || s == 2 || s == 4 || s == 7 || s == 8 || s == 10 || s == 11)) || ((PROBE & 2) && s == 6) || ((PROBE & 4) && (s == 5 || s == 6)) || ((PROBE & 8) && (s == 0 || s == 3 || s == 9))) ? 1 : 0;
}
constexpr int probe_player() { int n = 0; for (int s = 0; s < 12; ++s) n += 1 + probe_dup(s); return n; }
constexpr int PLAYER = probe_player();
constexpr int N_PHASES = 2 + 2 * PLAYER;
__global__ void __launch_bounds__(NTHR, 2) mega_fwd(Args a0) {
    extern __shared__ __attribute__((aligned(16))) unsigned char lds_raw[];
    LAS unsigned char* lds = (LAS unsigned char*)lds_raw;
    cg::grid_group grid = cg::this_grid();
    volatile LAS unsigned* bst = (volatile LAS unsigned*)(lds + LDS_MISC + 64);
    if (threadIdx.x < 2) bst[threadIdx.x] = 0u;
    __syncthreads();
    XcdBarrier xbar = xcd_barrier_post((unsigned*)(a0.ws + WS_BAR), bst);
    const int G = gridDim.x, bx = blockIdx.x;
    const int ph_lo = a0.ph_lo, ph_hi = a0.ph_hi;
    for (int p = ph_lo; p < ph_hi; ++p) {
        ArgsP ap = (ArgsP)__builtin_amdgcn_kernarg_segment_ptr(); asm volatile("" : "+s"(ap));
        const Args& a = *(const Args*)ap;
        unsigned char* ws = a.ws;
        bf16_t* H = (bf16_t*)(ws + WS_H); bf16_t* ACT = (bf16_t*)(ws + WS_ACT);
        bf16_t* Qb = (bf16_t*)(ws + WS_Q); bf16_t* Kb = (bf16_t*)(ws + WS_K); bf16_t* Vb = (bf16_t*)(ws + WS_V);
        bf16_t* LXb = (bf16_t*)(ws + WS_LX); bf16_t* LGb = (bf16_t*)(ws + WS_LG); bf16_t* GTb = (bf16_t*)(ws + WS_GT);
        const float* mod = (const float*)(ws + WS_MOD);
        float* X = a.out;
        if (p == 0) { phase_mod_rope(a, lds); }
        else if (p == N_PHASES - 1) { phase_final_norm(X, a.in[I_FING]); }
        else {
#if PROBE
            int l, s; bool dry = false;
            { int r = p - 1; l = r / PLAYER; r -= l * PLAYER;
              for (s = 0; s < 12; ++s) { const int n = 1 + probe_dup(s); if (r < n) { dry = (r + 1 < n); break; } r -= n; } }
#else
            const int l = (p - 1) / 12, s = (p - 1) % 12; constexpr bool dry = false;
#endif
            if (s == 3 || s == 9 || s == 5) continue;
            const float* modl = mod + (size_t)l * 8 * NMODV;
            const float* xin0 = (l == 0) ? a.in[I_X] : (const float*)X;
            switch (s) {
            case 0: {
                phase_convert_weights(a, l, lds);
                if (l == 0) phase_norm(xin0, a.in[I_NORMG], modl, 0, 1, H);
            } break;
#ifndef NO_G1
            case 1: case 10: {
                pg8::Gemm g{s == 1 ? H : (const bf16_t*)(ws + WS_XB2), (const bf16_t*)(ws + (s == 1 ? W_UP1 : W_UP2)), NT_TOK, NUP, DM}; pg8::StaticOrder S; S.init(NT_TOK, NUP, G, bx);
                EpiSwiglu E{ap, l, s};
                pg8::gemm_phase<EpiSwiglu, pg8::StaticOrder, true, true>(lds, g, S, E);
            } break;
#endif
#ifndef NO_G2
            case 2: case 8: case 11: {
                const bf16_t* A = s == 8 ? H : ACT; const bf16_t* Bt = (const bf16_t*)(ws + (s == 2 ? W_DN1 : (s == 8 ? W_OUT : W_DN2)));
                pg8::Gemm g{A, Bt, NT_TOK, DM, s == 8 ? DM : DFF}; pg8::StaticOrder S; S.init(NT_TOK, DM, G, bx);
                EpiResid E{ap, l, s, dry ? 1 : 0};
                pg8::gemm_phase<EpiResid, pg8::StaticOrder, true, true>(lds, g, S, E);
            } break;
#endif
#ifndef NO_G3
            case 4: {
                pg8::Gemm g{H, (const bf16_t*)(ws + W_IN), NT_TOK, INC, DM}; pg8::StaticOrder S; S.init(NT_TOK, INC, G, bx);
                EpiInproj E{ap, l, lds};
                pg8::gemm_phase<EpiInproj, pg8::StaticOrder, true, true>(lds, g, S, E);
            } break;
#endif
#ifndef NO_P5
            case 5: {
                if (!dry) phase_qk(Kb, a.in[I_KG] + l * 128, (const f32x2*)(ws + WS_ROPE));
            } break;
#endif
#ifndef NO_P6
            case 6: {
#ifndef NO_ATT
                if (!PROBE || (PROBE & 2) || !dry) for (int it = bx; it < NB * 8 * 16; it += G) {
                    const int b = it & 7, u = it >> 3, h = u >> 4, qb = u & 15;
                    const size_t qoff = ((size_t)(b * SEQ + qb * 256)) * DM + h * 128, koff = (size_t)b * SEQ * 256 + (h >> 2) * 128;
                    att::attn_dense_body(Qb + qoff, Kb + koff, Vb + koff, (dry ? H : Qb) + qoff, SEQ, (char*)lds_raw, a.in[I_QG] + l * 128, (const float*)(ws + WS_ROPE), qb * 256);
                    __syncthreads();
                }
#endif
#ifndef NO_LRU1
                if (!dry) phase_lru_chain(a, l, lds);
#endif
            } break;
#endif
#ifndef NO_G4
            case 7: {
                for (int h2 = 0; h2 < 2; ++h2) {
                    pg8::Gemm g{h2 ? LGb : Qb, (const bf16_t*)(ws + (h2 ? W_LO : W_AO)), NT_TOK, DM, DM}; pg8::StaticOrder S; S.init(NT_TOK, DM, G, bx);
                    EpiGate E{ap, h2};
                    pg8::gemm_phase<EpiGate, pg8::StaticOrder, true, true>(lds, g, S, E);
                    __syncthreads();
                }
            } break;
#endif
            default: break;
            }
        }
        if (p + 1 < ph_hi) { if (p == 0) grid.sync(); else xcd_barrier(xbar); if (PROBE & 16) xcd_barrier(xbar); }
    }
}

extern "C" void kernel_launch(void* const* d_in, const int* in_sizes, int n_in, void* d_out, int out_size, void* d_ws, size_t ws_size, hipStream_t stream) {
    static int grid = 0;
    if (grid == 0) {
        if (n_in != 23 || ws_size < WS_END) { fprintf(stderr, "kernel_launch: unexpected n_in %d or ws_size %zu (< %zu)\n", n_in, ws_size, (size_t)WS_END); grid = -1; return; }
        int dev = 0, cus = 0, per_cu = 0;
        hipGetDevice(&dev); hipDeviceGetAttribute(&cus, hipDeviceAttributeMultiprocessorCount, dev);
        if (hipFuncSetAttribute((const void*)mega_fwd, hipFuncAttributeMaxDynamicSharedMemorySize, LDS_BYTES) != hipSuccess) { fprintf(stderr, "kernel_launch: hipFuncSetAttribute failed\n"); grid = -1; return; }
        if (hipOccupancyMaxActiveBlocksPerMultiprocessor(&per_cu, (const void*)mega_fwd, NTHR, LDS_BYTES) != hipSuccess || per_cu < 1) { fprintf(stderr, "kernel_launch: occupancy query says %d\n", per_cu); per_cu = 1; }
        (void)hipGetLastError();
        grid = cus >= 256 ? 256 : cus;
    }
    if (grid < 0) return;
    if (hipMemsetAsync((char*)d_ws + WS_BAR, 0, BAR_BYTES, stream) != hipSuccess) { fprintf(stderr, "kernel_launch: memset failed\n"); return; }
    Args a{};
    for (int i = 0; i < 23; ++i) a.in[i] = (const float*)d_in[i];
    a.out = (float*)d_out; a.ws = (unsigned char*)d_ws;
#if MK_ONE_LAUNCH
    a.ph_lo = 0; a.ph_hi = N_PHASES;
    void* args[] = {&a};
    hipError_t e = hipLaunchCooperativeKernel((const void*)mega_fwd, dim3(grid), dim3(NTHR), args, LDS_BYTES, stream);
    if (e != hipSuccess) fprintf(stderr, "cooperative launch failed: %s (grid %d)\n", hipGetErrorString(e), grid);
#else
    for (int p = 0; p < N_PHASES; ++p) {
        a.ph_lo = p; a.ph_hi = p + 1;
        hipLaunchKernelGGL(mega_fwd, dim3(grid), dim3(NTHR), LDS_BYTES, stream, a);
    }
#endif
}
```

```cpp
#include <hip/hip_runtime.h>
#include <hip/hip_bf16.h>
#include <hip/hip_cooperative_groups.h>
#include <cstdio>
#include <cstdint>
namespace cg = cooperative_groups;
#ifndef MK_ONE_LAUNCH
#define MK_ONE_LAUNCH 1
#endif
__device__ __forceinline__ int opaque_tid() { int t = threadIdx.x; asm volatile("" : "+v"(t)); return t; }
#define LAS __attribute__((address_space(3)))
#define PROBE 0
#define XB_TMO      128
#define XB_XCNT(j)  (256  + 64 * (j))
#define XB_XSUB(j)  (1280 + 64 * (j))
#define XB_XGEN(j)  (2304 + 64 * (j))
#define XB_TOP      3328
#define XB_TOPGEN   3392
#define XCD_BAR_WORDS 3456
#define XB_SPIN_CAP (1u << 18)

__device__ __forceinline__ unsigned xb_ld(unsigned* p)              { return __hip_atomic_load(p, __ATOMIC_RELAXED, __HIP_MEMORY_SCOPE_AGENT); }
__device__ __forceinline__ unsigned xb_add(unsigned* p, unsigned v) { return __hip_atomic_fetch_add(p, v, __ATOMIC_RELAXED, __HIP_MEMORY_SCOPE_AGENT); }
__device__ __forceinline__ unsigned xb_xcc_id() { return (unsigned)__builtin_amdgcn_s_getreg((3 << 11) | 20) & 0xFu; }
#define XB_SPIN(cond, bar) do { unsigned _sp = 0; while (cond) { __builtin_amdgcn_s_sleep(1); \
    if ((++_sp & 255u) == 0u) { if (xb_ld(&(bar)[XB_TMO])) break; if (_sp > XB_SPIN_CAP) { atomicAdd(&(bar)[XB_TMO], 1u); break; } } } } while (0)

struct XcdBarrier {
    unsigned* bar; unsigned x;
    volatile LAS unsigned* st;
};

__device__ __forceinline__ XcdBarrier xcd_barrier_post(unsigned* bar, volatile LAS unsigned* st) {
    XcdBarrier b; b.bar = bar; b.x = xb_xcc_id(); b.st = st;
    if (threadIdx.x == 0) (void)xb_add(&bar[XB_XCNT(b.x)], 1u);
    return b;
}
__device__ __forceinline__ void xcd_barrier_complete(unsigned* bar, unsigned x, unsigned& nloc, unsigned& nx) {
    const unsigned G = gridDim.x * gridDim.y * gridDim.z;
    unsigned sum, cnt, mine, sp = 0u;
    for (;;) {
        sum = 0u; cnt = 0u; mine = 0u;
#pragma unroll
        for (unsigned j = 0; j < 16; ++j) { const unsigned c = xb_ld(&bar[XB_XCNT(j)]); sum += c; cnt += (c > 0u) ? 1u : 0u; mine = (j == x) ? c : mine; }
        if (sum == G) break;
        __builtin_amdgcn_s_sleep(1);
        if ((++sp & 255u) == 0u) { if (xb_ld(&bar[XB_TMO])) break; if (sp > XB_SPIN_CAP) { atomicAdd(&bar[XB_TMO], 1u); break; } }
    }
    nloc = mine > 0u ? mine : 1u; nx = cnt > 0u ? cnt : 1u;
}

__device__ __forceinline__ void xcd_barrier(const XcdBarrier& b) {
    asm volatile("s_waitcnt vmcnt(0)" ::: "memory");
    __syncthreads();
    if (threadIdx.x == 0) {
        unsigned* bar = b.bar;
        __builtin_amdgcn_s_waitcnt(0);
        unsigned nloc = b.st[0], nx = b.st[1];
        if (nloc == 0u) { xcd_barrier_complete(bar, b.x, nloc, nx); b.st[0] = nloc; b.st[1] = nx; }
        const unsigned old = xb_add(&bar[XB_XSUB(b.x)], 1u);
        const unsigned gen = old / nloc;
        if (old + 1u == (gen + 1u) * nloc) {
            __builtin_amdgcn_fence(__ATOMIC_RELEASE, "agent");
            asm volatile("s_waitcnt vmcnt(0)" ::: "memory");
            const unsigned og = xb_add(&bar[XB_TOP], 1u);
            const unsigned tg = og / nx;
            if (og + 1u == (tg + 1u) * nx) xb_add(&bar[XB_TOPGEN], 1u);
            else XB_SPIN(xb_ld(&bar[XB_TOPGEN]) == tg, bar);
            __builtin_amdgcn_fence(__ATOMIC_ACQUIRE, "agent");
            xb_add(&bar[XB_XGEN(b.x)], 1u);
            asm volatile("s_waitcnt vmcnt(0)" ::: "memory");
        } else {
            XB_SPIN(xb_ld(&bar[XB_XGEN(b.x)]) == gen, bar);
            __builtin_amdgcn_fence(__ATOMIC_ACQUIRE, "agent");
            asm volatile("s_waitcnt vmcnt(0)" ::: "memory");
        }
    }
    __syncthreads();
}
namespace pg8 {
#define PG8_LAS __attribute__((address_space(3)))
typedef unsigned short bf16_t;
typedef short bf16x8 __attribute__((ext_vector_type(8)));
typedef float f32x4 __attribute__((ext_vector_type(4)));
typedef unsigned u32x4 __attribute__((ext_vector_type(4)));
constexpr int BM = 256, BK = 64, HALF = 128, HTB = HALF * BK * 2  , STAGE_BYTES = 8 * HTB, NXCD = 8, WGM = 8;

__host__ __device__ __forceinline__ int lds_byte(int r, int c) { const int st = (r >> 4) * 2 + (c >> 5), rr = r & 15, cc = c & 31, ob = rr * 64 + cc * 2; return st * 1024 + (ob ^ (((ob >> 9) & 1) << 5)); }
__host__ __device__ __forceinline__ void stage_rc(int b, int& R, int& C) { const int st = b / 1024, sb = b % 1024, swz = sb ^ (((sb >> 9) & 1) << 5); R = (st >> 1) * 16 + swz / 64; C = (st & 1) * 32 + (swz % 64) / 2; }
__host__ __device__ __forceinline__ int perm32(int rho) { const int n = rho >> 4, i = rho & 15; return 8 * (i >> 2) + 4 * n + (i & 3); }

struct Unit { int pm, pn; };
struct Gemm { const bf16_t* A; const bf16_t* Bt; int M, N, K; };

struct StaticOrder {
    int nM, nN, nwg, G, c;
    __host__ __device__ void init(int M, int N, int G_, int c_) { nM = M / BM; nN = N / BM; nwg = nM * nN; G = G_; c = c_; }
    __host__ __device__ bool next(int i, Unit& u) const {
        const long L = (long)i * G + c; if (L >= nwg) return false;
        int wgid = (int)L; { const int q = nwg / NXCD, r = nwg % NXCD, xcd = wgid % NXCD, off = wgid / NXCD; wgid = (xcd < r ? xcd * (q + 1) : r * (q + 1) + (xcd - r) * q) + off; }
        const int nig = WGM * nN, gid = wgid / nig, fm = gid * WGM, gsz = (nM - fm) < WGM ? (nM - fm) : WGM;
        u.pm = fm + ((wgid % nig) % gsz); u.pn = (wgid % nig) / gsz; return true;
    }
    __device__ __forceinline__ void a_ready(const Unit&) const {}
    __device__ __forceinline__ void done(const Unit&) const {}
};

__device__ __forceinline__ unsigned cvt_pk_bf16(float lo, float hi) { unsigned r; asm volatile("v_cvt_pk_bf16_f32 %0, %1, %2" : "=v"(r) : "v"(lo), "v"(hi)); return r; }
typedef float f32x2 __attribute__((ext_vector_type(2)));
__device__ __forceinline__ f32x2 gelu_pk(f32x2 v) {
    const f32x2 av = __builtin_elementwise_abs(v), d = av * 0.2316418882f + 1.0f;
    f32x2 t; t.x = __builtin_amdgcn_rcpf(d.x); t.y = __builtin_amdgcn_rcpf(d.y);
    f32x2 q = t * 0.5307027145f + (-0.7265760135f); q = q * t + 0.7107068705f; q = q * t + (-0.142248368f); q = q * t + 0.127414796f; q = q * t;
    const f32x2 s = (v * v) * (-0.72134752044f);
    f32x2 e; e.x = __builtin_amdgcn_exp2f(s.x); e.y = __builtin_amdgcn_exp2f(s.y);
    const f32x2 m = v * (q * e), r = v - m;
    f32x2 o; o.x = v.x < 0.f ? m.x : r.x; o.y = v.y < 0.f ? m.y : r.y; return o;
}

template <int ACT  > struct EpiBf16 {
    static constexpr bool PERM = true, AFTER_DRAIN = false; static_assert(ACT == 0 || ACT == 1, "EpiBf16: ACT is 0 (none) or 1 (gelu_pk)");
    bf16_t* O; int ldc; const float* bias; int split_cols; size_t split_stride; float scale0;
    __device__ __forceinline__ void operator()(const f32x4 (&acc)[2][2][4][2], const Unit& u, int wr, int wc, int fr, int fq) const {
        const int row0 = u.pm * BM + wr * 64 + fr; int colt = u.pn * BM; bf16_t* base = O;
        float sc = 1.f; if (split_cols) { const int t = colt / split_cols; base += (size_t)t * split_stride; colt -= t * split_cols; if (t == 0) sc = scale0; }
        const int col0 = colt + wc * 32 + 8 * fq, bcol0 = u.pn * BM + wc * 32 + 8 * fq;
        f32x4 bv[2][2];
#pragma unroll
        for (int bj = 0; bj < 2; ++bj)
#pragma unroll
            for (int n = 0; n < 2; ++n) bv[bj][n] = bias ? *(const f32x4*)(bias + bcol0 + bj * HALF + 4 * n) : (f32x4){0.f, 0.f, 0.f, 0.f};
#pragma unroll
        for (int ai = 0; ai < 2; ++ai)
#pragma unroll
            for (int m = 0; m < 4; ++m) { bf16_t* rowp = base + (size_t)(row0 + ai * HALF + m * 16) * ldc + col0;
#pragma unroll
                for (int bj = 0; bj < 2; ++bj) { f32x4 v0 = acc[ai][bj][m][0] + bv[bj][0], v1 = acc[ai][bj][m][1] + bv[bj][1];
                    if (ACT == 1) { f32x2 a = gelu_pk((f32x2){v0[0], v0[1]}), b = gelu_pk((f32x2){v0[2], v0[3]}), c = gelu_pk((f32x2){v1[0], v1[1]}), d = gelu_pk((f32x2){v1[2], v1[3]});
                        v0 = (f32x4){a.x, a.y, b.x, b.y}; v1 = (f32x4){c.x, c.y, d.x, d.y}; }
                    v0 = v0 * sc; v1 = v1 * sc; u32x4 w; w.x = cvt_pk_bf16(v0[0], v0[1]); w.y = cvt_pk_bf16(v0[2], v0[3]); w.z = cvt_pk_bf16(v1[0], v1[1]); w.w = cvt_pk_bf16(v1[2], v1[3]);
                    *(u32x4*)(rowp + bj * HALF) = w; } }
    }
};
template <class Epi, class Sched, bool ALIGN_EPI = false, bool SP2 = false>
__device__ __forceinline__ void gemm_phase(PG8_LAS unsigned char* lds, const Gemm g, const Sched& S, const Epi& E) {
    const int tid = opaque_tid(), wid = __builtin_amdgcn_readfirstlane(tid >> 6), lane = tid & 63, wr = wid >> 2, wc = wid & 3, fr = lane & 15, fq = lane >> 4;
    const int K = g.K, nt = K / BK;
    unsigned voffA[2], voffB[2];
#pragma unroll
    for (int i = 0; i < 2; ++i) { int R, C; stage_rc(tid * 16 + i * 8192, R, C); const int Rb = Epi::PERM ? ((R & ~31) + perm32(R & 31)) : R;
        voffA[i] = (unsigned)(R * K + C) * 2u; voffB[i] = (unsigned)(Rb * K + C) * 2u; }
    const unsigned kstep = (unsigned)(BK * 2);
    const unsigned hstep = (unsigned)HALF * K * 2;
    const unsigned tstep = 2 * hstep;
    const __amdgpu_buffer_rsrc_t rA = __builtin_amdgcn_make_buffer_rsrc((void*)g.A, (short)0, (int)((size_t)g.M * K * 2), 0x00020000);
    const __amdgpu_buffer_rsrc_t rB = __builtin_amdgcn_make_buffer_rsrc((void*)g.Bt, (short)0, (int)((size_t)g.N * K * 2), 0x00020000);
    const unsigned ldsw = (unsigned)wid * 1024u;
    const int aoff = lds_byte(wr * 64 + fr, fq * 8), boff = lds_byte(wc * 32 + fr, fq * 8);
#define PG8_SA(b, h) (((b) * 2 + (h)) * HTB)
#define PG8_SB(b, h) ((4 + (b) * 2 + (h)) * HTB)
#define PG8_STAGEX(bufoff, rs, soff, voff) do { _Pragma("unroll") for (int _i = 0; _i < 2; ++_i) \
        __builtin_amdgcn_raw_ptr_buffer_load_lds(rs, (PG8_LAS unsigned*)(lds + (bufoff) + ldsw + _i * 8192), 16, (int)(voff)[_i], (int)(soff), 0, 0); } while (0)
#define PG8_LDA(dst, b, h) do { _Pragma("unroll") for (int m = 0; m < 4; ++m) _Pragma("unroll") for (int k = 0; k < 2; ++k) dst[m][k] = *(const PG8_LAS bf16x8*)(lds + PG8_SA(b, h) + aoff + m * 2048 + k * 1024); } while (0)
#define PG8_LDB(dst, b, h) do { _Pragma("unroll") for (int n = 0; n < 2; ++n) _Pragma("unroll") for (int k = 0; k < 2; ++k) dst[n][k] = *(const PG8_LAS bf16x8*)(lds + PG8_SB(b, h) + boff + n * 2048 + k * 1024); } while (0)
#define PG8_MMA(ai, bj, At, Bt) do { __builtin_amdgcn_s_setprio(1); _Pragma("unroll") for (int m = 0; m < 4; ++m) _Pragma("unroll") for (int n = 0; n < 2; ++n) _Pragma("unroll") for (int k = 0; k < 2; ++k) \
        acc[ai][bj][m][n] = __builtin_amdgcn_mfma_f32_16x16x32_bf16(Bt[n][k], At[m][k], acc[ai][bj][m][n], 0, 0, 0); __builtin_amdgcn_s_setprio(0); } while (0)
#define PG8_WAIT_V(n) asm volatile("s_waitcnt vmcnt(" #n ")" ::: "memory")
#define PG8_WAIT_L(n) asm volatile("s_waitcnt lgkmcnt(" #n ")" ::: "memory")
#define PG8_BAR __builtin_amdgcn_s_barrier()
#define PG8_SCHED __builtin_amdgcn_sched_barrier(0)
    Unit cur, nxt; int ui = 0;
    if (!S.next(0, cur)) return;
    f32x4 acc[2][2][4][2];
#pragma unroll
    for (int a = 0; a < 2; ++a)
#pragma unroll
        for (int b = 0; b < 2; ++b)
#pragma unroll
            for (int m = 0; m < 4; ++m)
#pragma unroll
                for (int n = 0; n < 2; ++n) acc[a][b][m][n] = (f32x4){0.f, 0.f, 0.f, 0.f};
    bf16x8 At[4][2], B0[2][2], B1[2][2];
    unsigned cA = (unsigned)cur.pm * tstep, cB = (unsigned)cur.pn * tstep;
    S.a_ready(cur);
    if constexpr (SP2) {
        PG8_STAGEX(PG8_SB(0, 0), rB, cB, voffB); PG8_STAGEX(PG8_SB(0, 1), rB, cB + hstep, voffB); PG8_STAGEX(PG8_SA(0, 0), rA, cA, voffA); PG8_STAGEX(PG8_SA(0, 1), rA, cA + hstep, voffA);
        if (wr == 1) PG8_BAR;
        PG8_WAIT_V(2); PG8_BAR;
        PG8_STAGEX(PG8_SB(1, 0), rB, cB + kstep, voffB); PG8_STAGEX(PG8_SA(1, 0), rA, cA + kstep, voffA); PG8_STAGEX(PG8_SB(1, 1), rB, cB + hstep + kstep, voffB);
        PG8_WAIT_V(6); PG8_BAR;
    } else {
        PG8_STAGEX(PG8_SB(0, 0), rB, cB, voffB); PG8_STAGEX(PG8_SA(0, 0), rA, cA, voffA); PG8_STAGEX(PG8_SB(0, 1), rB, cB + hstep, voffB); PG8_STAGEX(PG8_SA(0, 1), rA, cA + hstep, voffA);
        if (wr == 1) PG8_BAR;
        PG8_WAIT_V(4); PG8_BAR;
        PG8_STAGEX(PG8_SB(1, 0), rB, cB + kstep, voffB); PG8_STAGEX(PG8_SA(1, 0), rA, cA + kstep, voffA); PG8_STAGEX(PG8_SB(1, 1), rB, cB + hstep + kstep, voffB);
        PG8_WAIT_V(6); PG8_BAR;
    }
    for (;;) {
        const bool has_next = S.next(ui + 1, nxt);
        const unsigned nA = has_next ? (unsigned)nxt.pm * tstep : cA, nB = has_next ? (unsigned)nxt.pn * tstep : cB;
        for (int t = 0; t < nt; t += 2) {
            const bool last = (t == nt - 2);
            const unsigned a1 = cA + (unsigned)(t + 1) * kstep;
            const unsigned a2 = last ? nA : cA + (unsigned)(t + 2) * kstep, b2 = last ? nB : cB + (unsigned)(t + 2) * kstep;
            const unsigned a3 = a2 + kstep, b3 = b2 + kstep;
            if (last && has_next) S.a_ready(nxt);
            if constexpr (SP2) {
            PG8_LDB(B0, 0, 0); PG8_LDB(B1, 0, 1); PG8_SCHED; PG8_LDA(At, 0, 0); PG8_STAGEX(PG8_SA(1, 1), rA, a1 + hstep, voffA);
            PG8_WAIT_V(8); PG8_WAIT_L(0); PG8_BAR; PG8_MMA(0, 0, At, B0); PG8_MMA(0, 1, At, B1); PG8_BAR; PG8_SCHED;
            PG8_LDA(At, 0, 1); PG8_STAGEX(PG8_SB(0, 0), rB, b2, voffB); PG8_STAGEX(PG8_SB(0, 1), rB, b2 + hstep, voffB); PG8_STAGEX(PG8_SA(0, 0), rA, a2, voffA);
            PG8_WAIT_V(8); PG8_WAIT_L(0); PG8_BAR; PG8_MMA(1, 0, At, B0); PG8_MMA(1, 1, At, B1); PG8_BAR; PG8_SCHED;
            PG8_LDB(B0, 1, 0); PG8_LDB(B1, 1, 1); PG8_SCHED; PG8_LDA(At, 1, 0); PG8_STAGEX(PG8_SA(0, 1), rA, a2 + hstep, voffA);
            PG8_WAIT_V(8); PG8_WAIT_L(0); PG8_BAR; PG8_MMA(0, 0, At, B0); PG8_MMA(0, 1, At, B1); PG8_BAR; PG8_SCHED;
            PG8_LDA(At, 1, 1); PG8_STAGEX(PG8_SB(1, 0), rB, b3, voffB); PG8_STAGEX(PG8_SB(1, 1), rB, b3 + hstep, voffB); PG8_STAGEX(PG8_SA(1, 0), rA, a3, voffA);
            PG8_WAIT_V(8); PG8_WAIT_L(0); PG8_BAR; PG8_MMA(1, 0, At, B0); PG8_MMA(1, 1, At, B1); PG8_BAR; PG8_SCHED;
            } else {
            PG8_LDB(B0, 0, 0); PG8_SCHED; PG8_LDA(At, 0, 0); PG8_STAGEX(PG8_SA(1, 1), rA, a1 + hstep, voffA);
            PG8_WAIT_L(8); PG8_BAR; PG8_WAIT_L(0); PG8_MMA(0, 0, At, B0); PG8_BAR; PG8_SCHED;
            PG8_LDB(B1, 0, 1); PG8_STAGEX(PG8_SB(0, 0), rB, b2, voffB);
            PG8_BAR; PG8_WAIT_L(0); PG8_MMA(0, 1, At, B1); PG8_BAR;
            PG8_LDA(At, 0, 1); PG8_STAGEX(PG8_SA(0, 0), rA, a2, voffA);
            PG8_BAR; PG8_WAIT_L(0); PG8_MMA(1, 0, At, B0); PG8_BAR; PG8_SCHED;
            PG8_STAGEX(PG8_SB(0, 1), rB, b2 + hstep, voffB);
            PG8_WAIT_V(6); PG8_BAR; PG8_MMA(1, 1, At, B1); PG8_BAR;
            PG8_LDB(B0, 1, 0); PG8_SCHED; PG8_LDA(At, 1, 0); PG8_STAGEX(PG8_SA(0, 1), rA, a2 + hstep, voffA);
            PG8_WAIT_L(8); PG8_BAR; PG8_WAIT_L(0); PG8_MMA(0, 0, At, B0); PG8_BAR; PG8_SCHED;
            PG8_LDB(B1, 1, 1); PG8_STAGEX(PG8_SB(1, 0), rB, b3, voffB);
            PG8_BAR; PG8_WAIT_L(0); PG8_MMA(0, 1, At, B1); PG8_BAR;
            PG8_LDA(At, 1, 1); PG8_STAGEX(PG8_SA(1, 0), rA, a3, voffA);
            PG8_BAR; PG8_WAIT_L(0); PG8_MMA(1, 0, At, B0); PG8_BAR; PG8_SCHED;
            PG8_STAGEX(PG8_SB(1, 1), rB, b3 + hstep, voffB);
            PG8_WAIT_V(6); PG8_BAR; PG8_MMA(1, 1, At, B1); PG8_BAR;
            }
        }
        if constexpr (ALIGN_EPI) { if (wr == 0) PG8_BAR; }
        if constexpr (!Epi::AFTER_DRAIN) { E(acc, cur, wr, wc, fr, fq); S.done(cur); }
        if (!has_next) break;
#pragma unroll
        for (int a = 0; a < 2; ++a)
#pragma unroll
            for (int b = 0; b < 2; ++b)
#pragma unroll
                for (int m = 0; m < 4; ++m)
#pragma unroll
                    for (int n = 0; n < 2; ++n) acc[a][b][m][n] = (f32x4){0.f, 0.f, 0.f, 0.f};
        cur = nxt; cA = nA; cB = nB; ++ui;
        if constexpr (ALIGN_EPI) { if (wr == 1) PG8_BAR; }
    }
    PG8_WAIT_V(0);
    if constexpr (!ALIGN_EPI) { if (wr == 0) PG8_BAR; }
    PG8_BAR;
    if constexpr (Epi::AFTER_DRAIN) { E.fused(acc, cur, wr, wc, fr, fq, lds, wid, lane); S.done(cur); }
#undef PG8_SA
#undef PG8_SB
#undef PG8_STAGEX
#undef PG8_LDA
#undef PG8_LDB
#undef PG8_MMA
#undef PG8_WAIT_V
#undef PG8_WAIT_L
#undef PG8_BAR
#undef PG8_SCHED
}
}
namespace att {
typedef unsigned short bf16;
constexpr int   D = 128, NW = 8, QBLK = 32, KVBLK = 64;
constexpr float SCALE = 0.088388347648318440f;
constexpr float THR = 8.f;
constexpr int LDQ = 1024, LDK = 256, LDO = 1024;
constexpr size_t SHM_V = KVBLK * D * 2, SHM_K = KVBLK * D * 2, SHM_ATTN = 2 * SHM_V + 2 * SHM_K + NW * 64 * 4;
using bf16x8 = __attribute__((ext_vector_type(8))) short;
using s16x4  = __attribute__((ext_vector_type(4))) short;
using f32x16 = __attribute__((ext_vector_type(16))) float;
using u32x4  = __attribute__((ext_vector_type(4))) unsigned;
#define KSWZ(row, colB) ((row) * 256 + ((colB) ^ (((row) & 7) << 4)))
#define SBAR() __builtin_amdgcn_sched_barrier(0)
__device__ __forceinline__ int crow(int r, int hi) { return (r & 3) + 8 * (r >> 2) + 4 * hi; }
__device__ __forceinline__ unsigned cvtpk(float lo, float hi) {
  unsigned r; asm volatile("v_cvt_pk_bf16_f32 %0, %1, %2" : "=v"(r) : "v"(lo), "v"(hi)); return r;
}
__device__ __forceinline__ bf16x8 ld8(const bf16* p) { return *reinterpret_cast<const bf16x8*>(p); }

constexpr float THRL = THR * 1.4426950408889634f;
template <bool FIRST>
__device__ __forceinline__ void partialSM(f32x16& p0, f32x16& p1, float& m_reg, f32x16& negm, float& alpha) {
  float pmax = p0[0]; for (int r = 1; r < 16; ++r) pmax = fmaxf(pmax, p0[r]); for (int r = 0; r < 16; ++r) pmax = fmaxf(pmax, p1[r]);
  { auto rr = __builtin_amdgcn_permlane32_swap(__float_as_uint(pmax), __float_as_uint(pmax), false, false);
    pmax = fmaxf(__uint_as_float(rr[0]), __uint_as_float(rr[1])); }
  if (!FIRST && __builtin_expect(__all(pmax <= THRL), 1)) { alpha = 1.f; }
  else {
    const float d = FIRST ? pmax : fmaxf(pmax, 0.f);
    alpha = FIRST ? 1.f : __builtin_amdgcn_exp2f(-d);
    m_reg += d;
    for (int r = 0; r < 16; ++r) p0[r] -= d; for (int r = 0; r < 16; ++r) p1[r] -= d;
    const float nm = -m_reg; for (int r = 0; r < 16; ++r) negm[r] = nm;
  }
  for (int r = 0; r < 16; ++r) p0[r] = __builtin_amdgcn_exp2f(p0[r]);
}
__device__ __forceinline__ void finishSM(f32x16& p0, f32x16& p1, float alpha, float& l_reg, bf16x8& pa0, bf16x8& pa1, bf16x8& pa2, bf16x8& pa3) {
  for (int r = 0; r < 16; ++r) p1[r] = __builtin_amdgcn_exp2f(p1[r]);
  float ps = 0; for (int r = 0; r < 16; ++r) ps += p0[r]; for (int r = 0; r < 16; ++r) ps += p1[r];
  { auto rr = __builtin_amdgcn_permlane32_swap(__float_as_uint(ps), __float_as_uint(ps), false, false);
    ps = __uint_as_float(rr[0]) + __uint_as_float(rr[1]); }
  l_reg = l_reg * alpha + ps;
#define PK4(P, BASE, OUT) do { unsigned a0 = cvtpk(P[BASE + 0], P[BASE + 1]), a1 = cvtpk(P[BASE + 2], P[BASE + 3]);   \
    unsigned b0 = cvtpk(P[BASE + 4], P[BASE + 5]), b1 = cvtpk(P[BASE + 6], P[BASE + 7]);                              \
    auto r0 = __builtin_amdgcn_permlane32_swap(a0, b0, false, false); auto r1 = __builtin_amdgcn_permlane32_swap(a1, b1, false, false); \
    u32x4 w = {r0[0], r1[0], r0[1], r1[1]}; OUT = *reinterpret_cast<bf16x8*>(&w); } while (0)
  PK4(p0, 0, pa0); PK4(p0, 8, pa1); PK4(p1, 0, pa2); PK4(p1, 8, pa3);
#undef PK4
}
__device__ __forceinline__ void qkt(f32x16& p0, f32x16& p1, const bf16* Ks, const bf16x8* qr, const f32x16& negm, int r32, int hi) {
#pragma unroll
  for (int d0 = 0; d0 < 8; ++d0) { int cb = (d0 * 16 + hi * 8) * 2;
    bf16x8 b0 = *reinterpret_cast<const bf16x8*>((const char*)Ks + KSWZ(r32, cb));
    bf16x8 b1 = *reinterpret_cast<const bf16x8*>((const char*)Ks + KSWZ(32 + r32, cb));
    if (d0 == 0) { p0 = __builtin_amdgcn_mfma_f32_32x32x16_bf16(b0, qr[0], negm, 0, 0, 0); p1 = __builtin_amdgcn_mfma_f32_32x32x16_bf16(b1, qr[0], negm, 0, 0, 0); }
    else { p0 = __builtin_amdgcn_mfma_f32_32x32x16_bf16(b0, qr[d0], p0, 0, 0, 0); p1 = __builtin_amdgcn_mfma_f32_32x32x16_bf16(b1, qr[d0], p1, 0, 0, 0); } }
}
__device__ __forceinline__ int v_st(int k, int c) { const int kk = (k & ~0xC) | ((k & 4) << 1) | ((k & 8) >> 1); return ((kk >> 3) * 4 + (c >> 5)) * 512 + ((kk & 7) * 32 + (c & 31)) * 2; }
__device__ __forceinline__ int v_rd_base(int lane) { return ((lane & 3) << 3) | (((lane >> 2) & 3) << 6) | (((lane >> 4) & 1) << 5) | (((lane >> 5) & 1) << 8); }
constexpr int v_rd_off(int d0, int ks, int half) { return d0 * 512 + ks * 4096 + half * 2048; }
template <int OFF> __device__ __forceinline__ s16x4 tr_read(int vb) {
  s16x4 r; asm volatile("ds_read_b64_tr_b16 %0, %1 offset:%2" : "=&v"(r) : "v"(vb), "i"(OFF) : "memory"); return r;
}
template <int D0> __device__ __forceinline__ void pv_one(f32x16& od, int vb, bf16x8 pa0, bf16x8 pa1, bf16x8 pa2, bf16x8 pa3) {
  const s16x4 l0 = tr_read<v_rd_off(D0, 0, 0)>(vb), h0 = tr_read<v_rd_off(D0, 0, 1)>(vb), l1 = tr_read<v_rd_off(D0, 1, 0)>(vb), h1 = tr_read<v_rd_off(D0, 1, 1)>(vb);
  const s16x4 l2 = tr_read<v_rd_off(D0, 2, 0)>(vb), h2 = tr_read<v_rd_off(D0, 2, 1)>(vb), l3 = tr_read<v_rd_off(D0, 3, 0)>(vb), h3 = tr_read<v_rd_off(D0, 3, 1)>(vb);
  asm volatile("s_waitcnt lgkmcnt(0)" ::: "memory"); SBAR();
#define PK(L, H) (bf16x8){L[0], L[1], L[2], L[3], H[0], H[1], H[2], H[3]}
  od = __builtin_amdgcn_mfma_f32_32x32x16_bf16(pa0, PK(l0, h0), od, 0, 0, 0);
  od = __builtin_amdgcn_mfma_f32_32x32x16_bf16(pa1, PK(l1, h1), od, 0, 0, 0);
  od = __builtin_amdgcn_mfma_f32_32x32x16_bf16(pa2, PK(l2, h2), od, 0, 0, 0);
  od = __builtin_amdgcn_mfma_f32_32x32x16_bf16(pa3, PK(l3, h3), od, 0, 0, 0);
#undef PK
}
__device__ __forceinline__ void pv_d0(f32x16* o, int vb, bf16x8 pa0, bf16x8 pa1, bf16x8 pa2, bf16x8 pa3) {
  pv_one<0>(o[0], vb, pa0, pa1, pa2, pa3); pv_one<1>(o[1], vb, pa0, pa1, pa2, pa3); pv_one<2>(o[2], vb, pa0, pa1, pa2, pa3); pv_one<3>(o[3], vb, pa0, pa1, pa2, pa3);
}

__device__ __forceinline__ void attn_dense_body(const bf16* Qb, const bf16* __restrict__ Kh, const bf16* __restrict__ Vh,
                                                bf16* Ob, int seq, char* lds, const float* __restrict__ qg, const float* __restrict__ rope, int s0) {
  const int tid = opaque_tid(), wid = tid >> 6, lane = tid & 63, r32 = lane & 31, hi = lane >> 5;
  bf16* V_lds = (bf16*)lds; bf16* K_lds = (bf16*)(lds + 2 * SHM_V);
  float* ws = (float*)(lds + 2 * SHM_V + 2 * SHM_K) + wid * 64; float* li_l = ws; float* al_l = ws + 32;
  float m_reg = 0.f, l_reg = 0; f32x16 o[4] = {}; f32x16 negm = {}; bf16x8 qr[8];
  const bf16* Qw = Qb + (long)(wid * QBLK + r32) * LDQ + hi * 8;
#pragma unroll
  for (int d0 = 0; d0 < 8; ++d0) qr[d0] = ld8(Qw + d0 * 16);
  {
    float ss = 0.f;
#pragma unroll
    for (int d0 = 0; d0 < 8; ++d0)
#pragma unroll
      for (int e = 0; e < 8; ++e) { const float x = __uint_as_float((unsigned)(unsigned short)qr[d0][e] << 16); ss += x * x; }
    { auto rr = __builtin_amdgcn_permlane32_swap(__float_as_uint(ss), __float_as_uint(ss), false, false); ss = __uint_as_float(rr[0]) + __uint_as_float(rr[1]); }
    const float rstd = rsqrtf(ss * (1.f / 128.f) + 1e-6f) * (SCALE * 1.4426950408889634f);
    const float* rp = rope + (long)(s0 + wid * QBLK + r32) * 128 + hi * 8;
    const float* gp = qg + hi * 8;
#pragma unroll
    for (int d0 = 0; d0 < 8; ++d0) {
      const float4 g0 = *reinterpret_cast<const float4*>(gp + d0 * 16), g1 = *reinterpret_cast<const float4*>(gp + d0 * 16 + 4);
      const float4 c0 = *reinterpret_cast<const float4*>(rp + d0 * 16), c1 = *reinterpret_cast<const float4*>(rp + d0 * 16 + 4);
      const float gg[8] = {g0.x, g0.y, g0.z, g0.w, g1.x, g1.y, g1.z, g1.w};
      const float cs[8] = {c0.x, c0.y, c0.z, c0.w, c1.x, c1.y, c1.z, c1.w};
      unsigned w[4];
#pragma unroll
      for (int p = 0; p < 4; ++p) {
        const float y0 = __uint_as_float((unsigned)(unsigned short)qr[d0][2 * p] << 16) * rstd * gg[2 * p], y1 = __uint_as_float((unsigned)(unsigned short)qr[d0][2 * p + 1] << 16) * rstd * gg[2 * p + 1];
        w[p] = cvtpk(y0 * cs[2 * p] - y1 * cs[2 * p + 1], y0 * cs[2 * p + 1] + y1 * cs[2 * p]);
      }
      u32x4 ww = {w[0], w[1], w[2], w[3]}; qr[d0] = *reinterpret_cast<bf16x8*>(&ww);
    }
  }
  const int sr = tid >> 4, sc = (tid & 15) * 8, vst0 = v_st(sr, sc), vst1 = v_st(32 + sr, sc);
  const int vb0 = (int)(uintptr_t)V_lds + v_rd_base(lane);
  struct { bf16x8 vs0, vs1, ks0, ks1; } sr_[1];
  const __amdgpu_buffer_rsrc_t srK = __builtin_amdgcn_make_buffer_rsrc((void*)Kh, (short)0, seq * LDK * 2, 0x00020000);
  const __amdgpu_buffer_rsrc_t srV = __builtin_amdgcn_make_buffer_rsrc((void*)Vh, (short)0, seq * LDK * 2, 0x00020000);
  const unsigned kvoff = (unsigned)(sr * LDK + sc) * 2u;
#define BLD8(rs, vo, so) __builtin_bit_cast(bf16x8, __builtin_amdgcn_raw_buffer_load_b128(rs, vo, so, 0))
#define SLOAD(i, k0) do { const unsigned so_ = (unsigned)(k0) * (LDK * 2); \
    sr_[i].vs0 = BLD8(srV, kvoff, so_); sr_[i].vs1 = BLD8(srV, kvoff + 32u * LDK * 2u, so_); \
    sr_[i].ks0 = BLD8(srK, kvoff, so_); sr_[i].ks1 = BLD8(srK, kvoff + 32u * LDK * 2u, so_); } while (0)
#define SWRITE(b, i) do { *(bf16x8*)((char*)V_lds + (b) * SHM_V + vst0) = sr_[i].vs0;          \
    *(bf16x8*)((char*)V_lds + (b) * SHM_V + vst1) = sr_[i].vs1; int kc = sc * 2;               \
    *(bf16x8*)((char*)K_lds + (b) * SHM_K + KSWZ(sr, kc)) = sr_[i].ks0;                       \
    *(bf16x8*)((char*)K_lds + (b) * SHM_K + KSWZ(32 + sr, kc)) = sr_[i].ks1; } while (0)
#define SWAIT() asm volatile("s_waitcnt vmcnt(0)" ::: "memory")
#define RESC(a) do { if (__any((a) < 1.f)) { if (hi == 0) al_l[r32] = (a); asm volatile("s_waitcnt lgkmcnt(0)" ::: "memory"); \
    for (int d = 0; d < 4; ++d) for (int r = 0; r < 16; ++r) o[d][r] *= al_l[crow(r, hi)]; } } while (0)
  f32x16 pA0, pA1, pB0, pB1; float alA, alB; bf16x8 pa0, pa1, pa2, pa3; const int NT = seq / KVBLK;
  constexpr int SE = 0, SO = 0;
  SLOAD(SE, 0); asm volatile("s_waitcnt vmcnt(0)" ::: "memory"); SWRITE(0, SE); __syncthreads();
  qkt(pA0, pA1, K_lds, qr, negm, r32, hi); partialSM<true>(pA0, pA1, m_reg, negm, alA);
  SLOAD(SO, KVBLK);
  SWAIT(); SWRITE(1, SO); __syncthreads();
  for (int j = 1; j + 1 < NT; j += 2) {
    SBAR(); qkt(pB0, pB1, (bf16*)((char*)K_lds + SHM_K), qr, negm, r32, hi);
    finishSM(pA0, pA1, alA, l_reg, pa0, pa1, pa2, pa3); SBAR();
    SLOAD(SO, (j + 1) * KVBLK); SBAR();
    pv_d0(o, vb0, pa0, pa1, pa2, pa3); partialSM<false>(pB0, pB1, m_reg, negm, alB);
    __syncthreads(); SWAIT(); SWRITE(0, SE);
    RESC(alB); __syncthreads();
    SBAR(); qkt(pA0, pA1, K_lds, qr, negm, r32, hi);
    finishSM(pB0, pB1, alB, l_reg, pa0, pa1, pa2, pa3); SBAR();
    SLOAD(SE, (j + 2) * KVBLK); SBAR();
    pv_d0(o, vb0 + (int)SHM_V, pa0, pa1, pa2, pa3); partialSM<false>(pA0, pA1, m_reg, negm, alA);
    __syncthreads(); SWAIT(); SWRITE(1, SO);
    RESC(alA); __syncthreads();
  }
  SBAR(); qkt(pB0, pB1, (bf16*)((char*)K_lds + SHM_K), qr, negm, r32, hi);
  finishSM(pA0, pA1, alA, l_reg, pa0, pa1, pa2, pa3); SBAR();
  pv_d0(o, vb0, pa0, pa1, pa2, pa3); partialSM<false>(pB0, pB1, m_reg, negm, alB);
  __syncthreads(); RESC(alB);
  finishSM(pB0, pB1, alB, l_reg, pa0, pa1, pa2, pa3); SBAR();
  pv_d0(o, vb0 + (int)SHM_V, pa0, pa1, pa2, pa3);
  if (hi == 0) li_l[r32] = l_reg; asm volatile("s_waitcnt lgkmcnt(0)" ::: "memory");
  float rli[16];
#pragma unroll
  for (int r = 0; r < 16; ++r) rli[r] = __builtin_amdgcn_rcpf(li_l[crow(r, hi)]);
  bf16* Ow = Ob + (long)(wid * QBLK) * LDO;
#pragma unroll
  for (int r = 0; r < 16; ++r) { int orow = crow(r, hi);
#pragma unroll
    for (int d0 = 0; d0 < 4; d0 += 2) {
      const unsigned w0 = cvtpk(o[d0][r] * rli[r], o[d0 + 1][r] * rli[r]);
      Ow[(long)orow * LDO + d0 * 32 + r32] = (bf16)(w0 & 0xffffu);
      Ow[(long)orow * LDO + (d0 + 1) * 32 + r32] = (bf16)(w0 >> 16);
    } }
#undef SLOAD
#undef BLD8
#undef SWRITE
#undef SWAIT
#undef RESC
}
#undef KSWZ
#undef SBAR
}
typedef unsigned short bf16_t;
typedef float f32x4 __attribute__((ext_vector_type(4)));
typedef float f32x2 __attribute__((ext_vector_type(2)));
typedef unsigned u32x4 __attribute__((ext_vector_type(4)));
typedef unsigned u32x2 __attribute__((ext_vector_type(2)));
typedef short bf16x8 __attribute__((ext_vector_type(8)));

constexpr int DM = 1024, NB = 8, SEQ = 4096, NT_TOK = NB * SEQ, DFF = 2816, NUP = 2 * DFF, INC = 5632, NMODV = 9 * DM;
constexpr int NWAVES = 8, NTHR = 512;
constexpr float EPSN = 1e-6f;
constexpr size_t MiB = 1u << 20;
constexpr size_t WS_BAR = 0, BAR_BYTES = 16384;
constexpr size_t WS_CNT = 16384;
constexpr size_t WS_RSS = 65536;
constexpr size_t WS_MOD = 1 * MiB;
constexpr size_t WS_ROPE = 2 * MiB;
constexpr size_t WS_CAR = 4 * MiB;
constexpr size_t WS_W = 8 * MiB;
constexpr size_t W_UP1 = WS_W, W_DN1 = W_UP1 + 11 * MiB, W_IN = W_DN1 + 11 * MiB / 2, W_AO = W_IN + 11 * MiB, W_LO = W_AO + 2 * MiB, W_OUT = W_LO + 2 * MiB,
                 W_UP2 = W_OUT + 2 * MiB, W_DN2 = W_UP2 + 11 * MiB, W_LRU = W_DN2 + 11 * MiB / 2, W_END = W_LRU + 1 * MiB;
constexpr size_t WS_SW = 488 * MiB, SW_LAYER = (size_t)3 * 8 * 5632 * 4;
constexpr size_t WS_H = 60 * MiB;
constexpr size_t WS_BIG = 124 * MiB;
constexpr size_t WS_Q = WS_BIG, WS_K = WS_Q + 64 * MiB, WS_V = WS_K + 16 * MiB, WS_LX = WS_V + 16 * MiB, WS_LG = WS_LX + 64 * MiB, WS_GT = WS_LG + 64 * MiB, WS_END = WS_GT + 128 * MiB;
constexpr size_t WS_XB2 = WS_BIG + 288 * MiB;
constexpr size_t WS_ACT = WS_BIG;
static_assert(W_END <= WS_H && WS_SW + 2 * SW_LAYER <= 512 * MiB && WS_RSS + 6 * (size_t)NT_TOK * 4 <= WS_MOD && WS_XB2 + 64 * MiB <= WS_END && WS_XB2 >= WS_ACT + (size_t)NT_TOK * DFF * 2 && WS_H + 64 * MiB <= WS_BIG && WS_ACT + (size_t)NT_TOK * DFF * 2 <= WS_END && WS_END <= 512 * MiB, "ws map");
constexpr size_t WS_GRAN = 476 * MiB, GRAN_WORDS = (size_t)64 * 2 * 32 * 128 * 3;
static_assert(WS_GRAN >= WS_END && WS_GRAN + GRAN_WORDS * 8 <= WS_SW, "granules");
constexpr int LDS_MISC = 141312, LDS_BYTES = LDS_MISC + 1024;

constexpr int TC = 128, NCHK = SEQ / TC;
constexpr int XC_STRIDE = 272;
constexpr int LDS_XC = 0, LDS_HF = 34816, HF_STRIDE = 132;
constexpr int LDS_APL = LDS_HF + 128 * HF_STRIDE * 4, APL_STRIDE = 136  , LDS_HIN = LDS_APL + 128 * APL_STRIDE * 2, LDS_CW = LDS_HIN + 512;
static_assert(LDS_CW + 2560 <= LDS_MISC, "lru lds");

struct Args { const float* in[23]; float* out; unsigned char* ws; int ph_lo, ph_hi; };
typedef const Args __attribute__((address_space(4)))* ArgsP;
enum { I_X = 0, I_C, I_ADAW, I_ADAB, I_NORMG, I_UP1, I_DN1, I_WIN, I_QG, I_KG, I_CONVW, I_CONVB, I_WA, I_BA, I_WX, I_BX, I_LAM, I_WAO, I_WLO, I_WOUT, I_UP2, I_DN2, I_FING };

__device__ __forceinline__ unsigned pk2(float lo, float hi) { return pg8::cvt_pk_bf16(lo, hi); }
__device__ __forceinline__ float bflo(unsigned u) { return __uint_as_float(u << 16); }
__device__ __forceinline__ float bfhi(unsigned u) { return __uint_as_float(u & 0xffff0000u); }
__device__ __forceinline__ float sigm(float x) { return __builtin_amdgcn_rcpf(1.f + __expf(-x)); }
__device__ __forceinline__ float wave_sum(float v) {
#pragma unroll
    for (int o = 1; o < 64; o <<= 1) v += __shfl_xor(v, o);
    return v;
}
#define LDS_WAIT() asm volatile("s_waitcnt lgkmcnt(0)" ::: "memory")


typedef const float __attribute__((address_space(4)))* cfp4;
__device__ __forceinline__ float sel16(cfp4 p, int fr) {
    float t8[8], t4[4], t2[2];
#pragma unroll
    for (int i = 0; i < 8; ++i) t8[i] = (fr & 1) ? p[2 * i + 1] : p[2 * i];
#pragma unroll
    for (int i = 0; i < 4; ++i) t4[i] = (fr & 2) ? t8[2 * i + 1] : t8[2 * i];
#pragma unroll
    for (int i = 0; i < 2; ++i) t2[i] = (fr & 4) ? t4[2 * i + 1] : t4[2 * i];
    return (fr & 8) ? t2[1] : t2[0];
}
__device__ __forceinline__ float sel4x8(cfp4 p, int fq, int e) {
    const float a0 = (fq & 1) ? p[8 + e] : p[e], a1 = (fq & 1) ? p[24 + e] : p[16 + e];
    return (fq & 2) ? a1 : a0;
}
struct EpiSwiglu {
    static constexpr bool PERM = true, AFTER_DRAIN = false;
    ArgsP ap; int l, s;
    __device__ __forceinline__ void operator()(const f32x4 (&acc)[2][2][4][2], const pg8::Unit& u, int wr, int wc, int fr, int fq) const {
        unsigned char* ws = ap->ws; bf16_t* O = (bf16_t*)(ws + WS_ACT);
        const int row0 = u.pm * 256 + wr * 64 + fr, col0 = u.pn * 128 + wc * 32 + 8 * fq;
#pragma unroll
        for (int ai = 0; ai < 2; ++ai)
#pragma unroll
            for (int m = 0; m < 4; ++m) {
                bf16_t* rowp = O + (size_t)(row0 + ai * 128 + m * 16) * DFF + col0;
                float v[8];
#pragma unroll
                for (int n = 0; n < 2; ++n)
#pragma unroll
                    for (int j = 0; j < 4; ++j) { const float g = acc[ai][0][m][n][j], up = acc[ai][1][m][n][j]; v[n * 4 + j] = g * sigm(g) * up; }
                u32x4 w; w.x = pk2(v[0], v[1]); w.y = pk2(v[2], v[3]); w.z = pk2(v[4], v[5]); w.w = pk2(v[6], v[7]);
                *(u32x4*)rowp = w;
            }
    }
};
struct EpiInproj {
    static constexpr bool PERM = true, AFTER_DRAIN = false;
    ArgsP ap; int l; LAS unsigned char* lds;
    __device__ __forceinline__ void operator()(const f32x4 (&acc)[2][2][4][2], const pg8::Unit& u, int wr, int wc, int fr, int fq) const {
        unsigned char* ws = ap->ws;
        bf16_t *Q = (bf16_t*)(ws + WS_Q), *K = (bf16_t*)(ws + WS_K), *V = (bf16_t*)(ws + WS_V), *LX = (bf16_t*)(ws + WS_LX), *LG = (bf16_t*)(ws + WS_LG), *GT = (bf16_t*)(ws + WS_GT);
        const int pn = u.pn; bf16_t* base; int ld, coff; bool sg = false;
        if (pn == 4) {
            LAS float* P = (LAS float*)(lds + 131072);
            const int rl0 = wr * 64 + fr;
#pragma unroll
            for (int ai = 0; ai < 2; ++ai)
#pragma unroll
                for (int m = 0; m < 4; ++m)
#pragma unroll
                    for (int bj = 0; bj < 2; ++bj) {
                        const f32x4 a0 = acc[ai][bj][m][0], a1 = acc[ai][bj][m][1];
                        const float ssq = ((a0.x * a0.x + a0.y * a0.y) + (a0.z * a0.z + a0.w * a0.w)) + ((a1.x * a1.x + a1.y * a1.y) + (a1.z * a1.z + a1.w * a1.w));
                        const unsigned us = __float_as_uint(ssq);
                        auto r = __builtin_amdgcn_permlane32_swap(us, us, false, false);
                        const float s1 = __uint_as_float(r[0]) + __uint_as_float(r[1]);
                        auto p = __builtin_amdgcn_permlane16_swap(__float_as_uint(s1), __float_as_uint(s1), false, false);
                        const float tot = __uint_as_float(p[0]) + __uint_as_float(p[1]);
                        if (fq == 0) P[((ai * 128 + m * 16 + rl0) * 2 + bj) * 4 + wc] = tot;
                    }
            asm volatile("s_waitcnt lgkmcnt(0)" ::: "memory"); __builtin_amdgcn_s_barrier(); asm volatile("" ::: "memory");
            const float* kg = ap->in[I_KG] + l * 128 + wc * 32 + 8 * fq;
            const float* rope = (const float*)(ws + WS_ROPE) + wc * 32 + 8 * fq;
            const f32x4 kg0 = *(const f32x4*)kg, kg1 = *(const f32x4*)(kg + 4);
            const int row0k = u.pm * 256 + wr * 64 + fr;
#pragma unroll
            for (int ai = 0; ai < 2; ++ai)
#pragma unroll
                for (int m = 0; m < 4; ++m) {
                    const int row = row0k + ai * 128 + m * 16, pos = row & (SEQ - 1);
                    const f32x4 c0 = *(const f32x4*)(rope + (size_t)pos * 128), c1 = *(const f32x4*)(rope + (size_t)pos * 128 + 4);
#pragma unroll
                    for (int bj = 0; bj < 2; ++bj) {
                        const f32x4 pp = *(const LAS f32x4*)(P + ((ai * 128 + m * 16 + rl0) * 2 + bj) * 4);
                        const float rstd = rsqrtf(((pp.x + pp.y) + (pp.z + pp.w)) * (1.f / 128.f) + EPSN);
                        const f32x4 y0 = acc[ai][bj][m][0] * rstd * kg0, y1 = acc[ai][bj][m][1] * rstd * kg1;
                        u32x4 w;
                        w.x = pk2(y0.x * c0.x - y0.y * c0.y, y0.x * c0.y + y0.y * c0.x); w.y = pk2(y0.z * c0.z - y0.w * c0.w, y0.z * c0.w + y0.w * c0.z);
                        w.z = pk2(y1.x * c1.x - y1.y * c1.y, y1.x * c1.y + y1.y * c1.x); w.w = pk2(y1.z * c1.z - y1.w * c1.w, y1.z * c1.w + y1.w * c1.z);
                        *(u32x4*)(K + (size_t)row * 256 + bj * 128 + wc * 32 + 8 * fq) = w;
                    }
                }
            return;
        }
        if (pn < 4) { base = Q; ld = 1024; coff = 256 * pn; }
        else if (pn == 4) { base = K; ld = 256; coff = 0; }
        else if (pn == 5) { base = V; ld = 256; coff = 0; }
        else if (pn < 10) { base = LX; ld = 1024; coff = 256 * (pn - 6); }
        else if (pn < 14) { base = LG; ld = 1024; coff = 256 * (pn - 10); }
        else { base = GT; ld = 2048; coff = 256 * (pn - 14); sg = true; }
        const int row0 = u.pm * 256 + wr * 64 + fr, col0 = coff + wc * 32 + 8 * fq;
#pragma unroll
        for (int ai = 0; ai < 2; ++ai)
#pragma unroll
            for (int m = 0; m < 4; ++m) {
                bf16_t* rowp = base + (size_t)(row0 + ai * 128 + m * 16) * ld + col0;
#pragma unroll
                for (int bj = 0; bj < 2; ++bj) {
                    f32x4 v0 = acc[ai][bj][m][0], v1 = acc[ai][bj][m][1];
                    if (sg) {
#pragma unroll
                        for (int j = 0; j < 4; ++j) { v0[j] = sigm(v0[j]); v1[j] = sigm(v1[j]); }
                    }
                    u32x4 w; w.x = pk2(v0[0], v0[1]); w.y = pk2(v0[2], v0[3]); w.z = pk2(v1[0], v1[1]); w.w = pk2(v1[2], v1[3]);
                    *(u32x4*)(rowp + bj * 128) = w;
                }
            }
    }
};
struct EpiResid {
    static constexpr bool PERM = false, AFTER_DRAIN = false;
    ArgsP ap; int l, s, dry;
    __device__ __forceinline__ void operator()(const f32x4 (&acc_)[2][2][4][2], const pg8::Unit& u, int wr, int wc, int fr, int fq) const {
        f32x4 (&acc)[2][2][4][2] = const_cast<f32x4 (&)[2][2][4][2]>(acc_);
        unsigned char* ws = ap->ws; float* xout = ap->out; const float* xin = (s == 2 && l == 0) ? ap->in[I_X] : (const float*)xout;
        const float* mod = (const float*)(ws + WS_MOD);
        const int gi = s == 2 ? 2 : (s == 8 ? 5 : 8);
        const float* gate = mod + (size_t)l * 8 * NMODV + (size_t)gi * DM;
        const float coef = dry ? 0.f : (s == 8 ? 1.f : 0.5f);
        const int nl = s == 11 ? l + 1 : l, nn = s == 2 ? 1 : (s == 8 ? 2 : 0);
        const bool has_next = !(dry || nl > 1) && gridDim.x == 256;
        bf16_t* xb = (bf16_t*)(ws + (s == 8 ? WS_XB2 : WS_H));
        float* rss = (float*)(ws + WS_RSS) + (size_t)((nl & 1) * 3 + nn) * NT_TOK;
        const int row0 = u.pm * 256 + wr * 64 + fr, col0 = u.pn * 256 + wc * 32 + 4 * fq, b = (u.pm * 256) >> 12;
        {
            const float* gp = gate + (size_t)b * NMODV + col0;
            f32x4 gv[2][2];
#pragma unroll
            for (int bj = 0; bj < 2; ++bj)
#pragma unroll
                for (int n = 0; n < 2; ++n) gv[bj][n] = *(const f32x4*)(gp + bj * 128 + n * 16) * coef;
#pragma unroll
            for (int ai = 0; ai < 2; ++ai)
#pragma unroll
                for (int m = 0; m < 4; ++m) {
                    const size_t off = (size_t)(row0 + ai * 128 + m * 16) * DM + col0;
                    float ssq = 0.f;
#pragma unroll
                    for (int bj = 0; bj < 2; ++bj)
#pragma unroll
                        for (int n = 0; n < 2; ++n) {
                            const f32x4 xi = *(const f32x4*)(xin + off + bj * 128 + n * 16);
                            const f32x4 o = xi + gv[bj][n] * acc[ai][bj][m][n];
                            *(f32x4*)(xout + off + bj * 128 + n * 16) = o;
                            acc[ai][bj][m][n] = o;
                            ssq += (o.x * o.x + o.y * o.y) + (o.z * o.z + o.w * o.w);
                        }
                    if (has_next) {
                        const unsigned us = __float_as_uint(ssq);
                        auto r = __builtin_amdgcn_permlane32_swap(us, us, false, false);
                        const float s1 = __uint_as_float(r[0]) + __uint_as_float(r[1]);
                        auto p = __builtin_amdgcn_permlane16_swap(__float_as_uint(s1), __float_as_uint(s1), false, false);
                        const float tot = __uint_as_float(p[0]) + __uint_as_float(p[1]);
                        if (fq == 0) atomicAdd(rss + row0 + ai * 128 + m * 16, tot);
                    }
                    if (m == 3) asm volatile("" ::: "memory");
                }
        }
        if (has_next) {
            unsigned* cnt = (unsigned*)(ws + WS_CNT) + (size_t)(((nl & 1) * 3 + nn) * 128 + u.pm) * 16;
            asm volatile("s_waitcnt vmcnt(0)" ::: "memory");
            if (fr == 0 && fq == 0) __hip_atomic_fetch_add(cnt, 1u, __ATOMIC_RELAXED, __HIP_MEMORY_SCOPE_AGENT);
            for (unsigned spins = 0; (unsigned)__builtin_amdgcn_readfirstlane(__hip_atomic_load(cnt, __ATOMIC_RELAXED, __HIP_MEMORY_SCOPE_AGENT)) < 32u; ) {
                __builtin_amdgcn_s_sleep(1); if (++spins > (1u << 22)) break; }
            asm volatile("" ::: "memory");
            const float* ng = ap->in[I_NORMG] + (size_t)((nl & 1) * 3 + nn) * DM + col0;
            const float* nsc = mod + (size_t)(nl & 1) * 8 * NMODV + (size_t)b * NMODV + (size_t)(3 * nn + 1) * DM + col0;
            const float* nsh = mod + (size_t)(nl & 1) * 8 * NMODV + (size_t)b * NMODV + (size_t)(3 * nn) * DM + col0;
            f32x4 gs[2][2], sh[2][2];
#pragma unroll
            for (int bj = 0; bj < 2; ++bj)
#pragma unroll
                for (int n = 0; n < 2; ++n) { gs[bj][n] = *(const f32x4*)(ng + bj * 128 + n * 16) * (*(const f32x4*)(nsc + bj * 128 + n * 16) + 1.f); sh[bj][n] = *(const f32x4*)(nsh + bj * 128 + n * 16); }
#pragma unroll
            for (int ai = 0; ai < 2; ++ai)
#pragma unroll
                for (int m = 0; m < 4; ++m) {
                    const int row = row0 + ai * 128 + m * 16;
                    const float rs = rsqrtf(__hip_atomic_load(rss + row, __ATOMIC_RELAXED, __HIP_MEMORY_SCOPE_AGENT) * (1.f / DM) + EPSN);
                    const size_t off = (size_t)row * DM + col0;
#pragma unroll
                    for (int bj = 0; bj < 2; ++bj)
#pragma unroll
                        for (int n = 0; n < 2; ++n) { const f32x4 y = acc[ai][bj][m][n] * rs * gs[bj][n] + sh[bj][n];
                            *(u32x2*)(xb + off + bj * 128 + n * 16) = (u32x2){pk2(y.x, y.y), pk2(y.z, y.w)}; }
                }
        }
    }
};
struct EpiGate {
    static constexpr bool PERM = true, AFTER_DRAIN = false;
    ArgsP ap; int second;
    __device__ __forceinline__ void operator()(const f32x4 (&acc)[2][2][4][2], const pg8::Unit& u, int wr, int wc, int fr, int fq) const {
        unsigned char* ws = ap->ws; bf16_t* H = (bf16_t*)(ws + WS_H); const bf16_t* GT = (const bf16_t*)(ws + WS_GT);
        const int row0 = u.pm * 256 + wr * 64 + fr, col0 = u.pn * 256 + wc * 32 + 8 * fq;
#pragma unroll
        for (int ai = 0; ai < 2; ++ai)
#pragma unroll
            for (int m = 0; m < 4; ++m) {
                const size_t r = (size_t)(row0 + ai * 128 + m * 16);
#pragma unroll
                for (int bj = 0; bj < 2; ++bj) {
                    const u32x4 g = *(const u32x4*)(GT + r * 2048 + second * 1024 + col0 + bj * 128);
                    const f32x4 a0 = acc[ai][bj][m][0], a1 = acc[ai][bj][m][1];
                    float v[8] = { bflo(g.x) * a0[0], bfhi(g.x) * a0[1], bflo(g.y) * a0[2], bfhi(g.y) * a0[3], bflo(g.z) * a1[0], bfhi(g.z) * a1[1], bflo(g.w) * a1[2], bfhi(g.w) * a1[3] };
                    bf16_t* hp = H + r * DM + col0 + bj * 128;
                    if (second) { const u32x4 h = *(const u32x4*)hp;
                        v[0] += bflo(h.x); v[1] += bfhi(h.x); v[2] += bflo(h.y); v[3] += bfhi(h.y); v[4] += bflo(h.z); v[5] += bfhi(h.z); v[6] += bflo(h.w); v[7] += bfhi(h.w); }
                    u32x4 w; w.x = pk2(v[0], v[1]); w.y = pk2(v[2], v[3]); w.z = pk2(v[4], v[5]); w.w = pk2(v[6], v[7]);
                    *(u32x4*)hp = w;
                }
            }
    }
};

__device__ __forceinline__ f32x4 gemv8_block(const float* W, int ldw, int col0, const LAS float* vec, LAS float* part, int tid) {
    const int lane = tid & 63, wave = tid >> 6;
    const float* w = W + (size_t)(wave * 128) * ldw + col0 + 4 * lane;
    f32x4 acc[8];
#pragma unroll
    for (int b = 0; b < 8; ++b) acc[b] = (f32x4){0.f, 0.f, 0.f, 0.f};
#pragma unroll 1
    for (int k0 = 0; k0 < 128; k0 += 32) {
        f32x4 wv[32];
#pragma unroll
        for (int i = 0; i < 32; ++i) wv[i] = __builtin_nontemporal_load((const f32x4*)(w + (size_t)(k0 + i) * ldw));
#pragma unroll
        for (int i = 0; i < 32; ++i)
#pragma unroll
            for (int b = 0; b < 8; ++b) acc[b] += wv[i] * vec[b * DM + wave * 128 + k0 + i];
    }
#pragma unroll
    for (int b = 0; b < 8; ++b) *(LAS f32x4*)(part + ((wave * 8 + b) * 64 + lane) * 4) = acc[b];
    __syncthreads();
    f32x4 s = {0.f, 0.f, 0.f, 0.f};
#pragma unroll
    for (int w8 = 0; w8 < 8; ++w8) s += *(const LAS f32x4*)(part + ((w8 * 8 + wave) * 64 + lane) * 4);
    __syncthreads();
    return s;
}
__device__ __forceinline__ void phase_mod_rope(const Args& a, LAS unsigned char* lds) {
    const int tid = opaque_tid(), lane = tid & 63, wave = tid >> 6; int G = gridDim.x; asm volatile("" : "+s"(G));
    LAS float* sc = (LAS float*)lds;
    LAS float* part = (LAS float*)(lds + 32768);
    float* mod = (float*)(a.ws + WS_MOD);
    if (blockIdx.x < 72) {
        const float* c = a.in[I_C];
        for (int i = tid; i < NB * DM; i += NTHR) { const float v = c[i]; sc[i] = v / (1.f + __expf(-v)); }
        __syncthreads();
        for (int item = blockIdx.x; item < 72; item += G) {
            const int l = item / 36, col0 = (item % 36) * 256;
            const f32x4 s = gemv8_block(a.in[I_ADAW] + (size_t)l * DM * NMODV, NMODV, col0, sc, part, tid);
            const int col = col0 + 4 * lane;
            *(f32x4*)(mod + (size_t)(l * 8 + wave) * NMODV + col) = s + *(const f32x4*)(a.in[I_ADAB] + l * NMODV + col);
        }
    }
    { unsigned long long* gz = (unsigned long long*)(a.ws + WS_GRAN); for (size_t e = (size_t)blockIdx.x * NTHR + tid; e < GRAN_WORDS; e += (size_t)G * NTHR) gz[e] = 0ull; }
    { unsigned* cz = (unsigned*)(a.ws + WS_CNT); for (int e = blockIdx.x * NTHR + tid; e < 6 * 128 * 16; e += G * NTHR) cz[e] = 0u; }
    { float* rz = (float*)(a.ws + WS_RSS); for (int e = blockIdx.x * NTHR + tid; e < 6 * NT_TOK; e += G * NTHR) rz[e] = 0.f; }
    f32x2* rope = (f32x2*)(a.ws + WS_ROPE);
    for (int e = blockIdx.x * NTHR + tid; e < SEQ * 64; e += G * NTHR) {
        const int s = e >> 6, i = e & 63, m = i & 31;
        const float invf = powf(10000.f, -(float)(2 * m) / 64.f);
        const float pos = (float)(i < 32 ? (s >> 6) : (s & 63));
        const float ang = pos * invf;
        rope[e] = (f32x2){cosf(ang), sinf(ang)};
    }
}

__device__ __forceinline__ void transpose_item(const float* W, int K, int N, bf16_t* WT, int kb, int n0, int outrow0, LAS float* scr, int lane, float sc = 1.f) {
    const int k0 = 64 * kb;
    float wv[32];
#pragma unroll
    for (int i = 0; i < 32; ++i) { const int kk = 2 * i + (lane >> 5); wv[i] = W[(size_t)(k0 + kk) * N + n0 + (lane & 31)]; }
#pragma unroll
    for (int i = 0; i < 32; ++i) { const int kk = 2 * i + (lane >> 5); scr[kk * 33 + (lane & 31)] = wv[i]; }
    LDS_WAIT();
    const int c = lane & 7;
#pragma unroll
    for (int j = 0; j < 4; ++j) { const int n = (lane >> 3) + 8 * j; const LAS float* s = scr + (8 * c) * 33 + n;
        u32x4 o; o.x = pk2(s[0 * 33] * sc, s[1 * 33] * sc); o.y = pk2(s[2 * 33] * sc, s[3 * 33] * sc); o.z = pk2(s[4 * 33] * sc, s[5 * 33] * sc); o.w = pk2(s[6 * 33] * sc, s[7 * 33] * sc);
        *(u32x4*)(WT + (size_t)(outrow0 + n) * K + k0 + 8 * c) = o; }
    LDS_WAIT();
}
__device__ __forceinline__ void phase_convert_weights(const Args& a, int l, LAS unsigned char* lds) {
    const int tid = opaque_tid(), lane = tid & 63, wave = tid >> 6;
    LAS float* scr = (LAS float*)(lds + wave * 16384);
    const int gw = blockIdx.x * NWAVES + wave, NGW = gridDim.x * NWAVES;
    constexpr int I_UP = 16 * 176, I_DN = 44 * 32, I_SQ = 16 * 32, I_L = 256;
    constexpr int NITEMS = 3 * I_UP + 2 * I_DN + 3 * I_SQ + I_L;
    unsigned char* ws = a.ws;
    for (int it = gw; it < NITEMS; it += NGW) {
        int r = it;
        if (r < 2 * I_UP) {
            const int which = r / I_UP; r -= which * I_UP;
            const float* W = a.in[which ? I_UP2 : I_UP1] + (size_t)l * DM * NUP; bf16_t* WT = (bf16_t*)(ws + (which ? W_UP2 : W_UP1));
            const int kb = r / 176, n0 = (r % 176) * 32, half = n0 / DFF, j = n0 % DFF;
            transpose_item(W, DM, NUP, WT, kb, n0, 256 * (j / 128) + 128 * half + (j % 128), scr, lane); continue; }
        r -= 2 * I_UP;
        if (r < I_UP) { const int kb = r / 176, n0 = (r % 176) * 32;
            transpose_item(a.in[I_WIN] + (size_t)l * DM * INC, DM, INC, (bf16_t*)(ws + W_IN), kb, n0, n0, scr, lane); continue; }
        r -= I_UP;
        if (r < 2 * I_DN) { const int which = r / I_DN; r -= which * I_DN;
            const int kb = r / 32, n0 = (r % 32) * 32;
            transpose_item(a.in[which ? I_DN2 : I_DN1] + (size_t)l * DFF * DM, DFF, DM, (bf16_t*)(ws + (which ? W_DN2 : W_DN1)), kb, n0, n0, scr, lane); continue; }
        r -= 2 * I_DN;
        if (r < 3 * I_SQ) { const int which = r / I_SQ; r -= which * I_SQ;
            const int kb = r / 32, n0 = (r % 32) * 32;
            const float* W = a.in[which == 0 ? I_WAO : (which == 1 ? I_WLO : I_WOUT)] + (size_t)l * DM * DM;
            bf16_t* WT = (bf16_t*)(ws + (which == 0 ? W_AO : (which == 1 ? W_LO : W_OUT)));
            transpose_item(W, DM, DM, WT, kb, n0, n0, scr, lane); continue; }
        r -= 3 * I_SQ;
        {
            const int mat = r >> 3, sub = r & 7, kb = sub >> 2, n0 = (sub & 3) * 32;
            const int type = mat & 1, d = (mat >> 1) & 1, hb = mat >> 2;
            const float* W = a.in[type ? I_WX : I_WA] + (size_t)(((l * 2 + d) * 8 + hb)) * 128 * 128;
            bf16_t* WT = (bf16_t*)(ws + W_LRU) + (size_t)((hb * 2 + d) * 2 + type) * 128 * 128;
            transpose_item(W, 128, 128, WT, kb, n0, n0, scr, lane, -1.4426950408889634f);
        }
    }
}


__device__ __forceinline__ void phase_sw(const Args& a, int l, LAS unsigned char* lds) {
    const int tid = opaque_tid(), lane = tid & 63, wave = tid >> 6, G = gridDim.x;
    LAS float* sh = (LAS float*)lds;
    LAS float* part = (LAS float*)(lds + 32768);
    const float* modl = (const float*)(a.ws + WS_MOD) + (size_t)l * 8 * NMODV;
    float* SW = (float*)(a.ws + WS_SW + (size_t)l * SW_LAYER);
    for (int item = blockIdx.x; item < 66; item += G) {
        const int mm = item / 22, col0 = (item % 22) * 256;
        for (int i = tid; i < NB * DM; i += NTHR) { const int b = i >> 10, k = i & 1023; sh[i] = modl[(size_t)(b * 9 + 3 * mm) * DM + k]; }
        __syncthreads();
        const f32x4 s = gemv8_block(a.in[mm == 0 ? I_UP1 : (mm == 1 ? I_WIN : I_UP2)] + (size_t)l * DM * INC, INC, col0, sh, part, tid);
        const int col = col0 + 4 * lane; int np = col;
        if (mm != 1) { const int half = col / DFF, j = col % DFF; np = 256 * (j / 128) + 128 * half + (j % 128); }
        *(f32x4*)(SW + (size_t)(mm * 8 + wave) * INC + np) = s;
    }
}

__device__ __forceinline__ void phase_norm(const float* xin, const float* g, const float* modl, int ishift, int iscale, bf16_t* H) {
    const int tid = opaque_tid(), lane = tid & 63, wave = tid >> 6;
    const int gw = blockIdx.x * NWAVES + wave, NGW = gridDim.x * NWAVES;
    f32x4 v[4], vn[4];
    if (gw < NT_TOK) {
#pragma unroll
        for (int j = 0; j < 4; ++j) v[j] = ((const f32x4*)(xin + (size_t)gw * DM) + lane)[64 * j];
    }
    for (int m = gw; m < NT_TOK; m += NGW) {
        const int b = m >> 12, mn = m + NGW;
        if (mn < NT_TOK) {
#pragma unroll
            for (int j = 0; j < 4; ++j) vn[j] = ((const f32x4*)(xin + (size_t)mn * DM) + lane)[64 * j];
        }
        const f32x4* gr = (const f32x4*)g + lane;
        const f32x4* shr = (const f32x4*)(modl + (size_t)(b * 9 + ishift) * DM) + lane;
        const f32x4* scr = (const f32x4*)(modl + (size_t)(b * 9 + iscale) * DM) + lane;
        float s = 0.f;
#pragma unroll
        for (int j = 0; j < 4; ++j) s += (v[j].x * v[j].x + v[j].y * v[j].y) + (v[j].z * v[j].z + v[j].w * v[j].w);
        const float rstd = rsqrtf(wave_sum(s) * (1.f / DM) + EPSN);
        u32x2* o8 = (u32x2*)(H + (size_t)m * DM) + lane;
#pragma unroll
        for (int j = 0; j < 4; ++j) { const f32x4 gg = gr[64 * j], sh = shr[64 * j], sl = scr[64 * j];
            const f32x4 y = v[j] * rstd * gg * (sl + 1.f) + sh;
            o8[64 * j] = (u32x2){pk2(y.x, y.y), pk2(y.z, y.w)}; }
#pragma unroll
        for (int j = 0; j < 4; ++j) v[j] = vn[j];
    }
}
__device__ __forceinline__ void phase_final_norm(float* x, const float* g) {
    const int tid = opaque_tid(), lane = tid & 63, wave = tid >> 6;
    const int gw = blockIdx.x * NWAVES + wave, NGW = gridDim.x * NWAVES;
    f32x4 v[4], vn[4];
    if (gw < NT_TOK) {
#pragma unroll
        for (int j = 0; j < 4; ++j) v[j] = ((const f32x4*)(x + (size_t)gw * DM) + lane)[64 * j];
    }
    for (int m = gw; m < NT_TOK; m += NGW) {
        const int mn = m + NGW;
        if (mn < NT_TOK) {
#pragma unroll
            for (int j = 0; j < 4; ++j) vn[j] = ((const f32x4*)(x + (size_t)mn * DM) + lane)[64 * j];
        }
        f32x4* xr = (f32x4*)(x + (size_t)m * DM) + lane; const f32x4* gr = (const f32x4*)g + lane;
        float s = 0.f;
#pragma unroll
        for (int j = 0; j < 4; ++j) s += (v[j].x * v[j].x + v[j].y * v[j].y) + (v[j].z * v[j].z + v[j].w * v[j].w);
        const float rstd = rsqrtf(wave_sum(s) * (1.f / DM) + EPSN);
#pragma unroll
        for (int j = 0; j < 4; ++j) xr[64 * j] = v[j] * rstd * gr[64 * j];
#pragma unroll
        for (int j = 0; j < 4; ++j) v[j] = vn[j];
    }
}
__device__ __forceinline__ void phase_qk(bf16_t* K, const float* kg, const f32x2* rope) {
    const int tid = opaque_tid(), lane = tid & 63, wave = tid >> 6;
    const int gw = blockIdx.x * NWAVES + wave, NGW = gridDim.x * NWAVES;
    const int d0 = (lane & 31) * 4;
    const f32x4 kgv = *(const f32x4*)(kg + d0);
    for (int m0 = gw; m0 < NT_TOK; m0 += 4 * NGW) {
        u32x2 r0[4]; f32x4 cs[4];
#pragma unroll
        for (int i = 0; i < 4; ++i) { const int m = m0 + i * NGW;
            if (m < NT_TOK) { r0[i] = *(const u32x2*)(K + (size_t)m * 256 + lane * 4); cs[i] = *(const f32x4*)((const float*)(rope + (size_t)(m & (SEQ - 1)) * 64 + (d0 >> 1))); } }
#pragma unroll
        for (int i = 0; i < 4; ++i) { const int m = m0 + i * NGW;
            if (m < NT_TOK) {
                const float x[4] = { bflo(r0[i].x), bfhi(r0[i].x), bflo(r0[i].y), bfhi(r0[i].y) };
                float ss = (x[0] * x[0] + x[1] * x[1]) + (x[2] * x[2] + x[3] * x[3]);
                ss += __shfl_xor(ss, 1); ss += __shfl_xor(ss, 2); ss += __shfl_xor(ss, 4); ss += __shfl_xor(ss, 8); ss += __shfl_xor(ss, 16);
                const float rstd = rsqrtf(ss * (1.f / 128.f) + EPSN);
                const float y0 = x[0] * rstd * kgv.x, y1 = x[1] * rstd * kgv.y, y2 = x[2] * rstd * kgv.z, y3 = x[3] * rstd * kgv.w;
                *(u32x2*)(K + (size_t)m * 256 + lane * 4) = (u32x2){pk2(y0 * cs[i].x - y1 * cs[i].y, y0 * cs[i].y + y1 * cs[i].x), pk2(y2 * cs[i].z - y3 * cs[i].w, y2 * cs[i].w + y3 * cs[i].z)};
            } }
    }
}


__device__ __forceinline__ float xlane16(float v, int d, int q) {
    const unsigned u = __float_as_uint(v);
    auto p = __builtin_amdgcn_permlane16_swap(u, u, false, false);
    if (d == 0) { auto t = __builtin_amdgcn_permlane32_swap(p[1], p[1], false, false);
                  return __uint_as_float((q & 1) ? p[0] : t[0]); }
    else        { auto t = __builtin_amdgcn_permlane32_swap(p[0], p[0], false, false);
                  return __uint_as_float((q & 1) ? t[1] : p[1]); }
}
__device__ __forceinline__ float xlane32(float v, int d) {
    const unsigned u = __float_as_uint(v);
    auto r = __builtin_amdgcn_permlane32_swap(u, u, false, false);
    return __uint_as_float(d == 0 ? r[0] : r[1]);
}
__device__ __forceinline__ float xlast(float v, int d) {
    const unsigned u = __float_as_uint(v);
    auto r = __builtin_amdgcn_permlane32_swap(u, u, false, false);
    const unsigned w = d == 0 ? r[1] : r[0];
    auto t = __builtin_amdgcn_permlane16_swap(w, w, false, false);
    return __uint_as_float(d == 0 ? t[1] : t[0]);
}
template <int MODE>
__device__ __forceinline__ void phase_lru(const Args& a, int l, LAS unsigned char* lds, bf16_t* LOUT) {
    const int tid = opaque_tid(), lane = tid & 63, wave = tid >> 6, cl = lane & 15, q = lane >> 4, G = gridDim.x;
    const bf16_t* LX = (const bf16_t*)(a.ws + WS_LX); const bf16_t* LG = (const bf16_t*)(a.ws + WS_LG);
    const bf16_t* WL = (const bf16_t*)(a.ws + W_LRU);
    f32x2* CAR = (f32x2*)(a.ws + WS_CAR);
    LAS float* hf = (LAS float*)(lds + LDS_HF);
    const int rt = tid >> 4, cgp = tid & 15;
    for (int it = blockIdx.x; it < NB * NCHK * 8; it += G) {
        const int hb = it & 7, bc = it >> 3, b = bc >> 5, c = bc & 31;
        const int chw = hb * 128 + wave * 16 + cl;
        {
            const int chb = hb * 128 + cgp * 8;
            float w[4][8], bias[8];
#pragma unroll
            for (int j = 0; j < 4; ++j) { const f32x4 w0 = *(const f32x4*)(a.in[I_CONVW] + (size_t)(l * 4 + j) * DM + chb), w1 = *(const f32x4*)(a.in[I_CONVW] + (size_t)(l * 4 + j) * DM + chb + 4);
                w[j][0] = w0.x; w[j][1] = w0.y; w[j][2] = w0.z; w[j][3] = w0.w; w[j][4] = w1.x; w[j][5] = w1.y; w[j][6] = w1.z; w[j][7] = w1.w; }
            { const f32x4 b0 = *(const f32x4*)(a.in[I_CONVB] + (size_t)l * DM + chb), b1 = *(const f32x4*)(a.in[I_CONVB] + (size_t)l * DM + chb + 4);
              bias[0] = b0.x; bias[1] = b0.y; bias[2] = b0.z; bias[3] = b0.w; bias[4] = b1.x; bias[5] = b1.y; bias[6] = b1.z; bias[7] = b1.w; }
            u32x4 raw[7];
#pragma unroll
            for (int i = 0; i < 7; ++i) { const int s = c * TC + 4 * rt - 2 + i;
                raw[i] = (s >= 0 && s < SEQ) ? *(const u32x4*)(LX + (size_t)(b * SEQ + s) * DM + chb) : (u32x4){0u, 0u, 0u, 0u}; }
#pragma unroll
            for (int o = 0; o < 4; ++o) {
                float y[8];
#pragma unroll
                for (int e = 0; e < 8; ++e) y[e] = bias[e];
#pragma unroll
                for (int j = 0; j < 4; ++j) { const u32x4 r = raw[o + j];
                    y[0] += bflo(r.x) * w[j][0]; y[1] += bfhi(r.x) * w[j][1]; y[2] += bflo(r.y) * w[j][2]; y[3] += bfhi(r.y) * w[j][3];
                    y[4] += bflo(r.z) * w[j][4]; y[5] += bfhi(r.z) * w[j][5]; y[6] += bflo(r.w) * w[j][6]; y[7] += bfhi(r.w) * w[j][7]; }
                *(LAS u32x4*)(lds + LDS_XC + (4 * rt + o) * XC_STRIDE + cgp * 16) = (u32x4){pk2(y[0], y[1]), pk2(y[2], y[3]), pk2(y[4], y[5]), pk2(y[6], y[7])};
            }
        }
        __syncthreads();
#pragma unroll 1
        for (int d = 0; d < 2; ++d) {
            bf16x8 wf[2][4];
#pragma unroll
            for (int ty = 0; ty < 2; ++ty)
#pragma unroll
                for (int ks = 0; ks < 4; ++ks)
                    wf[ty][ks] = *(const bf16x8*)(WL + (size_t)((hb * 2 + d) * 2 + ty) * 16384 + (wave * 16 + cl) * 128 + ks * 32 + q * 8);
            const float ba = a.in[I_BA][(l * 2 + d) * DM + chw], bx = a.in[I_BX][(l * 2 + d) * DM + chw];
            const float sp8 = -8.f * 1.4426950408889634f * log1pf(__expf(-a.in[I_LAM][(l * 2 + d) * DM + chw]));
            float hc = 0.f, lsum = 0.f;
            if (MODE == 1) {
                const f32x2* cp = CAR + (size_t)((b * 2 + d) * NCHK) * DM + chw;
#pragma unroll
                for (int g8 = 0; g8 < NCHK / 8; ++g8) {
                    f32x2 cv[8];
#pragma unroll
                    for (int e = 0; e < 8; ++e) { const int cc = d == 0 ? g8 * 8 + e : NCHK - 1 - (g8 * 8 + e); cv[e] = cp[(size_t)cc * DM]; }
#pragma unroll
                    for (int e = 0; e < 8; ++e) { const int cc = d == 0 ? g8 * 8 + e : NCHK - 1 - (g8 * 8 + e); const bool on = d == 0 ? cc < c : cc > c;
                        hc = (on ? cv[e].x : 1.f) * hc + (on ? cv[e].y : 0.f); }
                }
            }
            const int pos = d == 0 ? q : 3 - q;
#pragma unroll 1
            for (int hf4 = 0; hf4 < 2; ++hf4) {
                float av[4][4], uv[4][4], A4[4], H4[4];
#pragma unroll
                for (int mi = 0; mi < 4; ++mi) {
                    const int mt = d == 0 ? hf4 * 4 + mi : 7 - (hf4 * 4 + mi);
                    f32x4 accr = {0.f, 0.f, 0.f, 0.f}, acci = {0.f, 0.f, 0.f, 0.f};
#pragma unroll
                    for (int ks = 0; ks < 4; ++ks) {
                        const bf16x8 af = *(const LAS bf16x8*)(lds + LDS_XC + (mt * 16 + cl) * XC_STRIDE + ks * 64 + q * 16);
                        accr = __builtin_amdgcn_mfma_f32_16x16x32_bf16(af, wf[0][ks], accr, 0, 0, 0);
                        acci = __builtin_amdgcn_mfma_f32_16x16x32_bf16(af, wf[1][ks], acci, 0, 0, 0);
                    }
#pragma unroll
                    for (int j = 0; j < 4; ++j) {
                        const float xv = __uint_as_float((unsigned)(*(const LAS unsigned short*)(lds + LDS_XC + (mt * 16 + 4 * q + j) * XC_STRIDE + (wave * 16 + cl) * 2)) << 16);
                        const float rg = sigm(accr[j] + ba), ig = sigm(acci[j] + bx);
                        const float la = rg * sp8;
                        const float aa = __builtin_amdgcn_exp2f(la);
                        av[mi][j] = aa; uv[mi][j] = __builtin_amdgcn_sqrtf(fmaxf(1.f - aa * aa, 0.f)) * (ig * xv);
                        if (MODE == 0) lsum += la;
                    }
                    A4[mi] = (av[mi][0] * av[mi][1]) * (av[mi][2] * av[mi][3]);
                    if (d == 0) H4[mi] = ((uv[mi][0] * av[mi][1] + uv[mi][1]) * av[mi][2] + uv[mi][2]) * av[mi][3] + uv[mi][3];
                    else        H4[mi] = ((uv[mi][3] * av[mi][2] + uv[mi][2]) * av[mi][1] + uv[mi][1]) * av[mi][0] + uv[mi][0];
                }
                float Ae[4], He[4], At[4], Ht[4];
#pragma unroll
                for (int mi = 0; mi < 4; ++mi) {
                    { const float A1 = xlane16(A4[mi], d, q), H1 = xlane16(H4[mi], d, q); if (pos >= 1) { H4[mi] = A4[mi] * H1 + H4[mi]; A4[mi] = A4[mi] * A1; } }
                    { const float A2 = xlane32(A4[mi], d), H2 = xlane32(H4[mi], d); if (pos >= 2) { H4[mi] = A4[mi] * H2 + H4[mi]; A4[mi] = A4[mi] * A2; } }
                    Ae[mi] = xlane16(A4[mi], d, q); He[mi] = xlane16(H4[mi], d, q);
                    if (pos == 0) { Ae[mi] = 1.f; He[mi] = 0.f; }
                    At[mi] = xlast(A4[mi], d); Ht[mi] = xlast(H4[mi], d);
                }
#pragma unroll
                for (int mi = 0; mi < 4; ++mi) {
                    const int mt = d == 0 ? hf4 * 4 + mi : 7 - (hf4 * 4 + mi);
                    if (MODE == 1) {
                        float h = Ae[mi] * hc + He[mi];
                        if (d == 0) {
#pragma unroll
                            for (int j = 0; j < 4; ++j) { h = av[mi][j] * h + uv[mi][j]; hf[(mt * 16 + 4 * q + j) * HF_STRIDE + wave * 16 + cl] = h; }
                        } else {
#pragma unroll
                            for (int j = 3; j >= 0; --j) { h = av[mi][j] * h + uv[mi][j]; hf[(mt * 16 + 4 * q + j) * HF_STRIDE + wave * 16 + cl] += h; }
                        }
                    }
                    hc = At[mi] * hc + Ht[mi];
                }
            }
            if (MODE == 0) {
                lsum += __shfl_xor(lsum, 16); lsum += __shfl_xor(lsum, 32);
                if (q == 0) CAR[(size_t)((b * 2 + d) * NCHK + c) * DM + chw] = (f32x2){__builtin_amdgcn_exp2f(lsum), hc};
            }
        }
        __syncthreads();
        if (MODE == 1) {
#pragma unroll
            for (int o = 0; o < 4; ++o) {
                const int r = 4 * rt + o;
                const f32x4 h0 = *(const LAS f32x4*)(hf + r * HF_STRIDE + cgp * 8), h1 = *(const LAS f32x4*)(hf + r * HF_STRIDE + cgp * 8 + 4);
                const u32x4* gp = (const u32x4*)(LG + (size_t)(b * SEQ + c * TC + r) * DM + hb * 128 + cgp * 8);
                const u32x4 g = *gp;
                float x[8] = { bflo(g.x), bfhi(g.x), bflo(g.y), bfhi(g.y), bflo(g.z), bfhi(g.z), bflo(g.w), bfhi(g.w) };
                const float hh[8] = { h0.x, h0.y, h0.z, h0.w, h1.x, h1.y, h1.z, h1.w };
                float y[8];
#pragma unroll
                for (int e = 0; e < 8; ++e) { const float v = x[e]; const float t = 1.5957691216057308f * (v + 0.044715f * v * v * v); y[e] = hh[e] * (v * sigm(t)); }
                *(u32x4*)(LOUT + (size_t)(b * SEQ + c * TC + r) * DM + hb * 128 + cgp * 8) = (u32x4){pk2(y[0], y[1]), pk2(y[2], y[3]), pk2(y[4], y[5]), pk2(y[6], y[7])};
            }
            __syncthreads();
        }
    }
}


__device__ __forceinline__ float gran_wait(const unsigned long long* g, unsigned tag) {
    unsigned long long v; unsigned spins = 0;
    for (;;) { v = __hip_atomic_load(g, __ATOMIC_RELAXED, __HIP_MEMORY_SCOPE_AGENT); if ((unsigned)(v >> 32) == tag) break; __builtin_amdgcn_s_sleep(1); if (++spins > (1u << 22)) break; }
    return __uint_as_float((unsigned)v);
}
__device__ __forceinline__ void gran_put(unsigned long long* g, unsigned tag, float v) {
    __hip_atomic_store(g, ((unsigned long long)tag << 32) | (unsigned long long)__float_as_uint(v), __ATOMIC_RELAXED, __HIP_MEMORY_SCOPE_AGENT);
}
template <int D>
__device__ __forceinline__ void lru_chain_pass(const Args& a, int l, LAS unsigned char* lds, int chain, int j) {
    const int tid = opaque_tid(), lane = tid & 63, wave = tid >> 6, cl = lane & 15, q = lane >> 4;
    const int b = chain >> 3, hb = chain & 7, jj = D == 1 ? 3 - j : j;
    const bf16_t* LX = (const bf16_t*)(a.ws + WS_LX); bf16_t* LG = (bf16_t*)(a.ws + WS_LG); bf16_t* HB = (bf16_t*)(a.ws + WS_H);
    const bf16_t* WL = (const bf16_t*)(a.ws + W_LRU);
    LAS float* hf = (LAS float*)(lds + LDS_HF); LAS float* hin_s = (LAS float*)(lds + LDS_HIN); LAS float* cw = (LAS float*)(lds + LDS_CW);
    const int rt = tid >> 4, cgp = tid & 15;
    const int chl = wave * 16 + cl, chw = hb * 128 + chl, chb = hb * 128 + cgp * 8;
    for (int i = tid; i < 640; i += NTHR) { const int row = i >> 7, ch = i & 127; cw[i] = row < 4 ? a.in[I_CONVW][(size_t)(l * 4 + row) * DM + hb * 128 + ch] : a.in[I_CONVB][(size_t)l * DM + hb * 128 + ch]; }
    bf16x8 wf[2][4];
#pragma unroll
    for (int ty = 0; ty < 2; ++ty)
#pragma unroll
        for (int ks = 0; ks < 4; ++ks)
            wf[ty][ks] = *(const bf16x8*)(WL + (size_t)((hb * 2 + D) * 2 + ty) * 16384 + chl * 128 + ks * 32 + q * 8);
    const float ba = -1.4426950408889634f * a.in[I_BA][(l * 2 + D) * DM + chw], bx = -1.4426950408889634f * a.in[I_BX][(l * 2 + D) * DM + chw];
    const f32x4 ba4 = {ba, ba, ba, ba}, bx4 = {bx, bx, bx, bx};
    const float sp8 = -8.f * 1.4426950408889634f * log1pf(__expf(-a.in[I_LAM][(l * 2 + D) * DM + chw]));
    const int pos = D == 0 ? q : 3 - q;
    const int ak1 = (((D == 0 ? lane - 16 : lane + 16) & 63) << 2), ak2 = (((D == 0 ? lane - 32 : lane + 32) & 63) << 2), ak3 = (((D == 0 ? lane - 48 : lane + 48) & 63) << 2);
    const bool c1 = pos >= 1, c2 = pos >= 2, c3 = pos >= 3;
#define BPERM(ad, v) __int_as_float(__builtin_amdgcn_ds_bpermute((ad), __float_as_int(v)))
    const unsigned tag = (unsigned)l + 1u;
    unsigned long long* gb = (unsigned long long*)(a.ws + WS_GRAN) + (size_t)((chain * 2 + D) * 32) * 384 + (size_t)chl * 3;
#define LRU_CHUNK(r) (D == 1 ? 4 * (7 - (r)) + j : 4 * (r) + j)
#define LRU_LOAD_RAW(cc) do { _Pragma("unroll") for (int i = 0; i < 7; ++i) { const int s = (cc) * TC + 4 * rt - 2 + i; \
        raw[i] = (s >= 0 && s < SEQ) ? *(const u32x4*)(LX + (size_t)(b * SEQ + s) * DM + chb) : (u32x4){0u, 0u, 0u, 0u}; } } while (0)
    u32x4 raw[7];
    LRU_LOAD_RAW(LRU_CHUNK(0));
    __syncthreads();
#pragma unroll 1
    for (int r = 0; r < 8; ++r) {
        const int c = LRU_CHUNK(r);
        {
            float y[4][8];
            { const f32x4 b0 = *(const LAS f32x4*)(cw + 512 + cgp * 8), b1 = *(const LAS f32x4*)(cw + 512 + cgp * 8 + 4);
#pragma unroll
              for (int o = 0; o < 4; ++o) { y[o][0] = b0.x; y[o][1] = b0.y; y[o][2] = b0.z; y[o][3] = b0.w; y[o][4] = b1.x; y[o][5] = b1.y; y[o][6] = b1.z; y[o][7] = b1.w; } }
#pragma unroll
            for (int jt = 0; jt < 4; ++jt) {
                const f32x4 w0 = *(const LAS f32x4*)(cw + jt * 128 + cgp * 8), w1 = *(const LAS f32x4*)(cw + jt * 128 + cgp * 8 + 4);
#pragma unroll
                for (int o = 0; o < 4; ++o) { const u32x4 rr = raw[o + jt];
                    y[o][0] += bflo(rr.x) * w0.x; y[o][1] += bfhi(rr.x) * w0.y; y[o][2] += bflo(rr.y) * w0.z; y[o][3] += bfhi(rr.y) * w0.w;
                    y[o][4] += bflo(rr.z) * w1.x; y[o][5] += bfhi(rr.z) * w1.y; y[o][6] += bflo(rr.w) * w1.z; y[o][7] += bfhi(rr.w) * w1.w; }
            }
#pragma unroll
            for (int o = 0; o < 4; ++o)
                *(LAS u32x4*)(lds + LDS_XC + (4 * rt + o) * XC_STRIDE + cgp * 16) = (u32x4){pk2(y[o][0], y[o][1]), pk2(y[o][2], y[o][3]), pk2(y[o][4], y[o][5]), pk2(y[o][6], y[o][7])};
        }
        __syncthreads();
        if (r + 1 < 8) LRU_LOAD_RAW(LRU_CHUNK(r + 1));
        u32x4 pg[4], ph[4];
        if (D == 0) {
#pragma unroll
            for (int o = 0; o < 4; ++o) { const size_t goff = (size_t)(b * SEQ + c * TC + 4 * rt + o) * DM + chb; pg[o] = *(const u32x4*)(LG + goff); ph[o] = *(const u32x4*)(HB + goff); }
        }
        float hc = 0.f, Ac = 1.f;
#pragma unroll 1
        for (int hf4 = 0; hf4 < 2; ++hf4) {
            float av[4][4], uv[4][4], A4[4], H4[4];
#pragma unroll
            for (int mi = 0; mi < 4; ++mi) {
                const int mt = D == 0 ? hf4 * 4 + mi : 7 - (hf4 * 4 + mi);
                f32x4 accr, acci;
#pragma unroll
                for (int ks = 0; ks < 4; ++ks) {
                    const bf16x8 af = *(const LAS bf16x8*)(lds + LDS_XC + (mt * 16 + cl) * XC_STRIDE + ks * 64 + q * 16);
                    accr = __builtin_amdgcn_mfma_f32_16x16x32_bf16(af, wf[0][ks], ks == 0 ? ba4 : accr, 0, 0, 0);
                    acci = __builtin_amdgcn_mfma_f32_16x16x32_bf16(af, wf[1][ks], ks == 0 ? bx4 : acci, 0, 0, 0);
                }
#pragma unroll
                for (int jx = 0; jx < 4; ++jx) {
                    const float xv = __uint_as_float((unsigned)(*(const LAS unsigned short*)(lds + LDS_XC + (mt * 16 + 4 * q + jx) * XC_STRIDE + chl * 2)) << 16);
                    const float rg = __builtin_amdgcn_rcpf(1.f + __builtin_amdgcn_exp2f(accr[jx])), ig = __builtin_amdgcn_rcpf(1.f + __builtin_amdgcn_exp2f(acci[jx]));
                    const float aa = __builtin_amdgcn_exp2f(rg * sp8);
                    av[mi][jx] = aa; uv[mi][jx] = __builtin_amdgcn_sqrtf(fmaf(-aa, aa, 1.f)) * (ig * xv);
                }
                A4[mi] = (av[mi][0] * av[mi][1]) * (av[mi][2] * av[mi][3]);
                if (D == 0) H4[mi] = ((uv[mi][0] * av[mi][1] + uv[mi][1]) * av[mi][2] + uv[mi][2]) * av[mi][3] + uv[mi][3];
                else        H4[mi] = ((uv[mi][3] * av[mi][2] + uv[mi][2]) * av[mi][1] + uv[mi][1]) * av[mi][0] + uv[mi][0];
            }
            float Ae[4], He[4], At[4], Ht[4];
#pragma unroll
            for (int mi = 0; mi < 4; ++mi) {
                const float A1 = BPERM(ak1, A4[mi]), H1 = BPERM(ak1, H4[mi]), A2 = BPERM(ak2, A4[mi]), H2 = BPERM(ak2, H4[mi]), A3 = BPERM(ak3, A4[mi]), H3 = BPERM(ak3, H4[mi]);
                float eA = c3 ? A3 : 1.f, eH = c3 ? H3 : 0.f;
                { const float a = c2 ? A2 : 1.f, h = c2 ? H2 : 0.f; eH = a * eH + h; eA = a * eA; }
                { const float a = c1 ? A1 : 1.f, h = c1 ? H1 : 0.f; eH = a * eH + h; eA = a * eA; }
                Ae[mi] = eA; He[mi] = eH;
                float tA = A4[mi] * eA, tH = A4[mi] * eH + H4[mi];
                { const float a = c3 ? 1.f : A3, h = c3 ? 0.f : H3; tH = a * tH + h; tA = a * tA; }
                { const float a = c2 ? 1.f : A2, h = c2 ? 0.f : H2; tH = a * tH + h; tA = a * tA; }
                { const float a = c1 ? 1.f : A1, h = c1 ? 0.f : H1; tH = a * tH + h; tA = a * tA; }
                At[mi] = tA; Ht[mi] = tH;
            }
#pragma unroll
            for (int mi = 0; mi < 4; ++mi) {
                const int mt = D == 0 ? hf4 * 4 + mi : 7 - (hf4 * 4 + mi);
                float h = Ae[mi] * hc + He[mi], ap = Ac * Ae[mi];
#pragma unroll
                for (int jx = 0; jx < 4; ++jx) { const int jt = D == 0 ? jx : 3 - jx; const int t = mt * 16 + 4 * q + jt;
                    h = av[mi][jt] * h + uv[mi][jt]; ap = ap * av[mi][jt];
                    ((LAS unsigned*)hf)[t * HF_STRIDE + chl] = pk2(h, ap); }
                hc = At[mi] * hc + Ht[mi]; Ac = Ac * At[mi];
            }
        }
        if (q == 0) {
            const int rho = 4 * r + jj;
            if (jj < 3) { gran_put(gb + (size_t)rho * 384 + 1, tag, Ac); gran_put(gb + (size_t)rho * 384 + 2, tag, hc); }
            const unsigned long long* gq = gb + (size_t)(4 * r) * 384;
            const unsigned long long ready = (unsigned long long)tag << 32;
            unsigned long long gv[7];
            for (unsigned spins = 0;;) {
                gv[0] = r > 0 ? __hip_atomic_load(gq - 384, __ATOMIC_RELAXED, __HIP_MEMORY_SCOPE_AGENT) : ready;
#pragma unroll
                for (int k = 0; k < 3; ++k) {
                    gv[1 + 2 * k] = k < jj ? __hip_atomic_load(gq + k * 384 + 1, __ATOMIC_RELAXED, __HIP_MEMORY_SCOPE_AGENT) : ready;
                    gv[2 + 2 * k] = k < jj ? __hip_atomic_load(gq + k * 384 + 2, __ATOMIC_RELAXED, __HIP_MEMORY_SCOPE_AGENT) : ready;
                }
                bool ok = true;
#pragma unroll
                for (int i = 0; i < 7; ++i) ok = ok && ((unsigned)(gv[i] >> 32) == tag);
                if (ok) break;
                __builtin_amdgcn_s_sleep(1); if (++spins > (1u << 22)) break;
            }
            float hin = __uint_as_float((unsigned)gv[0]);
#pragma unroll
            for (int k = 0; k < 3; ++k) if (k < jj) hin = __uint_as_float((unsigned)gv[1 + 2 * k]) * hin + __uint_as_float((unsigned)gv[2 + 2 * k]);
            if (jj == 3) gran_put(gb + (size_t)rho * 384, tag, Ac * hin + hc);
            hin_s[chl] = hin;
        }
        __syncthreads();
#pragma unroll
        for (int o = 0; o < 4; ++o) {
            const int rr = 4 * rt + o;
            const u32x4 w0 = *(const LAS u32x4*)((const LAS unsigned*)hf + rr * HF_STRIDE + cgp * 8), w1 = *(const LAS u32x4*)((const LAS unsigned*)hf + rr * HF_STRIDE + cgp * 8 + 4);
            const f32x4 i0 = *(const LAS f32x4*)(hin_s + cgp * 8), i1 = *(const LAS f32x4*)(hin_s + cgp * 8 + 4);
            float hh[8] = { bflo(w0.x) + bfhi(w0.x) * i0.x, bflo(w0.y) + bfhi(w0.y) * i0.y, bflo(w0.z) + bfhi(w0.z) * i0.z, bflo(w0.w) + bfhi(w0.w) * i0.w,
                            bflo(w1.x) + bfhi(w1.x) * i1.x, bflo(w1.y) + bfhi(w1.y) * i1.y, bflo(w1.z) + bfhi(w1.z) * i1.z, bflo(w1.w) + bfhi(w1.w) * i1.w };
            const size_t goff = (size_t)(b * SEQ + c * TC + rr) * DM + chb;
            if (D == 1) {
                *(u32x4*)(HB + goff) = (u32x4){pk2(hh[0], hh[1]), pk2(hh[2], hh[3]), pk2(hh[4], hh[5]), pk2(hh[6], hh[7])};
            } else {
                const u32x4 g = pg[o], hbv = ph[o];
                const float x[8] = { bflo(g.x), bfhi(g.x), bflo(g.y), bfhi(g.y), bflo(g.z), bfhi(g.z), bflo(g.w), bfhi(g.w) };
                const float hb8[8] = { bflo(hbv.x), bfhi(hbv.x), bflo(hbv.y), bfhi(hbv.y), bflo(hbv.z), bfhi(hbv.z), bflo(hbv.w), bfhi(hbv.w) };
                float yy[8];
#pragma unroll
                for (int e = 0; e < 8; ++e) { const float v = x[e]; const float t = 1.5957691216057308f * (v + 0.044715f * v * v * v); yy[e] = (hh[e] + hb8[e]) * (v * sigm(t)); }
                *(u32x4*)(LG + goff) = (u32x4){pk2(yy[0], yy[1]), pk2(yy[2], yy[3]), pk2(yy[4], yy[5]), pk2(yy[6], yy[7])};
            }
        }
    }
    __syncthreads();
#undef LRU_CHUNK
#undef LRU_LOAD_RAW
#undef BPERM
}
__device__ __forceinline__ void phase_lru_chain(const Args& a, int l, LAS unsigned char* lds) {
    if (gridDim.x != 256) return;
    const int bx = blockIdx.x, chain = bx & 63, j = bx >> 6;
    lru_chain_pass<1>(a, l, lds, chain, j);
    lru_chain_pass<0>(a, l, lds, chain, j);
}

#ifndef PROBE
#define PROBE 0
#endif
__host__ __device__ constexpr int probe_dup(int s) {
    return (((PROBE & 1) && (s == 1 || s == 2 || s == 4 || s == 7 || s == 8 || s == 10 || s == 11)) || ((PROBE & 2) && s == 6) || ((PROBE & 4) && (s == 5 || s == 6)) || ((PROBE & 8) && (s == 0 || s == 3 || s == 9))) ? 1 : 0;
}
constexpr int probe_player() { int n = 0; for (int s = 0; s < 12; ++s) n += 1 + probe_dup(s); return n; }
constexpr int PLAYER = probe_player();
constexpr int N_PHASES = 2 + 2 * PLAYER;
__global__ void __launch_bounds__(NTHR, 2) mega_fwd(Args a0) {
    extern __shared__ __attribute__((aligned(16))) unsigned char lds_raw[];
    LAS unsigned char* lds = (LAS unsigned char*)lds_raw;
    cg::grid_group grid = cg::this_grid();
    volatile LAS unsigned* bst = (volatile LAS unsigned*)(lds + LDS_MISC + 64);
    if (threadIdx.x < 2) bst[threadIdx.x] = 0u;
    __syncthreads();
    XcdBarrier xbar = xcd_barrier_post((unsigned*)(a0.ws + WS_BAR), bst);
    const int G = gridDim.x, bx = blockIdx.x;
    const int ph_lo = a0.ph_lo, ph_hi = a0.ph_hi;
    for (int p = ph_lo; p < ph_hi; ++p) {
        ArgsP ap = (ArgsP)__builtin_amdgcn_kernarg_segment_ptr(); asm volatile("" : "+s"(ap));
        const Args& a = *(const Args*)ap;
        unsigned char* ws = a.ws;
        bf16_t* H = (bf16_t*)(ws + WS_H); bf16_t* ACT = (bf16_t*)(ws + WS_ACT);
        bf16_t* Qb = (bf16_t*)(ws + WS_Q); bf16_t* Kb = (bf16_t*)(ws + WS_K); bf16_t* Vb = (bf16_t*)(ws + WS_V);
        bf16_t* LXb = (bf16_t*)(ws + WS_LX); bf16_t* LGb = (bf16_t*)(ws + WS_LG); bf16_t* GTb = (bf16_t*)(ws + WS_GT);
        const float* mod = (const float*)(ws + WS_MOD);
        float* X = a.out;
        if (p == 0) { phase_mod_rope(a, lds); }
        else if (p == N_PHASES - 1) { phase_final_norm(X, a.in[I_FING]); }
        else {
#if PROBE
            int l, s; bool dry = false;
            { int r = p - 1; l = r / PLAYER; r -= l * PLAYER;
              for (s = 0; s < 12; ++s) { const int n = 1 + probe_dup(s); if (r < n) { dry = (r + 1 < n); break; } r -= n; } }
#else
            const int l = (p - 1) / 12, s = (p - 1) % 12; constexpr bool dry = false;
#endif
            if (s == 3 || s == 9 || s == 5) continue;
            const float* modl = mod + (size_t)l * 8 * NMODV;
            const float* xin0 = (l == 0) ? a.in[I_X] : (const float*)X;
            switch (s) {
            case 0: {
                phase_convert_weights(a, l, lds);
                if (l == 0) phase_norm(xin0, a.in[I_NORMG], modl, 0, 1, H);
            } break;
#ifndef NO_G1
            case 1: case 10: {
                pg8::Gemm g{s == 1 ? H : (const bf16_t*)(ws + WS_XB2), (const bf16_t*)(ws + (s == 1 ? W_UP1 : W_UP2)), NT_TOK, NUP, DM}; pg8::StaticOrder S; S.init(NT_TOK, NUP, G, bx);
                EpiSwiglu E{ap, l, s};
                pg8::gemm_phase<EpiSwiglu, pg8::StaticOrder, true, true>(lds, g, S, E);
            } break;
#endif
#ifndef NO_G2
            case 2: case 8: case 11: {
                const bf16_t* A = s == 8 ? H : ACT; const bf16_t* Bt = (const bf16_t*)(ws + (s == 2 ? W_DN1 : (s == 8 ? W_OUT : W_DN2)));
                pg8::Gemm g{A, Bt, NT_TOK, DM, s == 8 ? DM : DFF}; pg8::StaticOrder S; S.init(NT_TOK, DM, G, bx);
                EpiResid E{ap, l, s, dry ? 1 : 0};
                pg8::gemm_phase<EpiResid, pg8::StaticOrder, true, true>(lds, g, S, E);
            } break;
#endif
#ifndef NO_G3
            case 4: {
                pg8::Gemm g{H, (const bf16_t*)(ws + W_IN), NT_TOK, INC, DM}; pg8::StaticOrder S; S.init(NT_TOK, INC, G, bx);
                EpiInproj E{ap, l, lds};
                pg8::gemm_phase<EpiInproj, pg8::StaticOrder, true, true>(lds, g, S, E);
            } break;
#endif
#ifndef NO_P5
            case 5: {
                if (!dry) phase_qk(Kb, a.in[I_KG] + l * 128, (const f32x2*)(ws + WS_ROPE));
            } break;
#endif
#ifndef NO_P6
            case 6: {
#ifndef NO_ATT
                if (!PROBE || (PROBE & 2) || !dry) for (int it = bx; it < NB * 8 * 16; it += G) {
                    const int b = it & 7, u = it >> 3, h = u >> 4, qb = u & 15;
                    const size_t qoff = ((size_t)(b * SEQ + qb * 256)) * DM + h * 128, koff = (size_t)b * SEQ * 256 + (h >> 2) * 128;
                    att::attn_dense_body(Qb + qoff, Kb + koff, Vb + koff, (dry ? H : Qb) + qoff, SEQ, (char*)lds_raw, a.in[I_QG] + l * 128, (const float*)(ws + WS_ROPE), qb * 256);
                    __syncthreads();
                }
#endif
#ifndef NO_LRU1
                if (!dry) phase_lru_chain(a, l, lds);
#endif
            } break;
#endif
#ifndef NO_G4
            case 7: {
                for (int h2 = 0; h2 < 2; ++h2) {
                    pg8::Gemm g{h2 ? LGb : Qb, (const bf16_t*)(ws + (h2 ? W_LO : W_AO)), NT_TOK, DM, DM}; pg8::StaticOrder S; S.init(NT_TOK, DM, G, bx);
                    EpiGate E{ap, h2};
                    pg8::gemm_phase<EpiGate, pg8::StaticOrder, true, true>(lds, g, S, E);
                    __syncthreads();
                }
            } break;
#endif
            default: break;
            }
        }
        if (p + 1 < ph_hi) { if (p == 0) grid.sync(); else xcd_barrier(xbar); if (PROBE & 16) xcd_barrier(xbar); }
    }
}

extern "C" void kernel_launch(void* const* d_in, const int* in_sizes, int n_in, void* d_out, int out_size, void* d_ws, size_t ws_size, hipStream_t stream) {
    static int grid = 0;
    if (grid == 0) {
        if (n_in != 23 || ws_size < WS_END) { fprintf(stderr, "kernel_launch: unexpected n_in %d or ws_size %zu (< %zu)\n", n_in, ws_size, (size_t)WS_END); grid = -1; return; }
        int dev = 0, cus = 0, per_cu = 0;
        hipGetDevice(&dev); hipDeviceGetAttribute(&cus, hipDeviceAttributeMultiprocessorCount, dev);
        if (hipFuncSetAttribute((const void*)mega_fwd, hipFuncAttributeMaxDynamicSharedMemorySize, LDS_BYTES) != hipSuccess) { fprintf(stderr, "kernel_launch: hipFuncSetAttribute failed\n"); grid = -1; return; }
        if (hipOccupancyMaxActiveBlocksPerMultiprocessor(&per_cu, (const void*)mega_fwd, NTHR, LDS_BYTES) != hipSuccess || per_cu < 1) { fprintf(stderr, "kernel_launch: occupancy query says %d\n", per_cu); per_cu = 1; }
        (void)hipGetLastError();
        grid = cus >= 256 ? 256 : cus;
    }
    if (grid < 0) return;
    if (hipMemsetAsync((char*)d_ws + WS_BAR, 0, BAR_BYTES, stream) != hipSuccess) { fprintf(stderr, "kernel_launch: memset failed\n"); return; }
    Args a{};
    for (int i = 0; i < 23; ++i) a.in[i] = (const float*)d_in[i];
    a.out = (float*)d_out; a.ws = (unsigned char*)d_ws;
#if MK_ONE_LAUNCH
    a.ph_lo = 0; a.ph_hi = N_PHASES;
    void* args[] = {&a};
    hipError_t e = hipLaunchCooperativeKernel((const void*)mega_fwd, dim3(grid), dim3(NTHR), args, LDS_BYTES, stream);
    if (e != hipSuccess) fprintf(stderr, "cooperative launch failed: %s (grid %d)\n", hipGetErrorString(e), grid);
#else
    for (int p = 0; p < N_PHASES; ++p) {
        a.ph_lo = p; a.ph_hi = p + 1;
        hipLaunchKernelGGL(mega_fwd, dim3(grid), dim3(NTHR), LDS_BYTES, stream, a);
    }
#endif
}
```
